# Optimizing an MI355X kernel written in HIP

```python
import math
import jax, jax.numpy as jnp
from jax import lax
import numpy as np

D_MODEL = 2048
BATCH = 2
SEQ = 8192
DEPTH = 2

HEAD_DIM = 128
N_HEADS_A = D_MODEL // (2 * HEAD_DIM)
N_HEADS_B = D_MODEL // (2 * HEAD_DIM)
WIDTH_A = N_HEADS_A * HEAD_DIM
WIDTH_B = N_HEADS_B * HEAD_DIM
DILATED_BRANCHES = ((128, 1), (512, 4), (2048, 16))
DIL_BLOCK = 128
MOBA_BLOCK = 256
MOBA_TOPK = 3
MOBA_Q_CHUNK = 64
N_HEADS_C = D_MODEL // (2 * HEAD_DIM)
D_FF = 256 * (-(-(8 * D_MODEL // 3) // 256))
ROPE_THETA = 10000.0
NORM_EPS = 1e-6
SUBLN_EPS = 1e-5
DENSE_Q_BLOCK = 128
NEG_INF = -1e30
N_EVEN = (DEPTH + 1) // 2
N_ODD = DEPTH // 2

kernel_name = "hybrid_dilated_moba_diffattn_macaron"


def rmsnorm(x, g, eps=NORM_EPS):
    xf = x.astype(jnp.float32)
    y = xf * lax.rsqrt(jnp.mean(xf * xf, axis=-1, keepdims=True) + eps)
    return (y * g.astype(jnp.float32)).astype(x.dtype)


def rope(x):
    S, D = x.shape[-2], x.shape[-1]
    half = D // 2
    inv_freq = ROPE_THETA ** (-jnp.arange(half, dtype=jnp.float32) / half)
    ang = jnp.arange(S, dtype=jnp.float32)[:, None] * inv_freq[None, :]
    cos, sin = jnp.cos(ang), jnp.sin(ang)
    xf = x.astype(jnp.float32)
    x1, x2 = xf[..., :half], xf[..., half:]
    return jnp.concatenate([x1 * cos - x2 * sin, x2 * cos + x1 * sin], axis=-1).astype(x.dtype)


def swiglu(x, w_in, w_out):
    g, u = jnp.split(x @ w_in, 2, axis=-1)
    return (jax.nn.silu(g) * u) @ w_out


def dilated_branch(q, k, v, window, dilation):
    B, H, S, D = q.shape
    L = S // dilation
    reach = window // dilation
    Q = DIL_BLOCK
    nblk = -(-L // Q)
    Lp = nblk * Q

    def strided_blocks(t):
        t = t.reshape(B, H, L, dilation, D).transpose(0, 1, 3, 2, 4)
        t = jnp.pad(t, ((0, 0), (0, 0), (0, 0), (0, Lp - L), (0, 0)))
        return t.reshape(B, H, dilation, nblk, Q, D)

    def with_prev(t):
        prev = jnp.pad(t[:, :, :, :-1], ((0, 0), (0, 0), (0, 0), (1, 0), (0, 0), (0, 0)))
        return jnp.concatenate([prev, t], axis=4)

    qb = strided_blocks(q)
    kw = with_prev(strided_blocks(k))
    vw = with_prev(strided_blocks(v))
    qi = jnp.arange(Q)[:, None] + Q
    kj = jnp.arange(2 * Q)[None, :]
    dist = qi - kj
    blk = jnp.arange(nblk)[:, None, None]
    mask = (dist >= 0) & (dist <= reach) & (blk * Q + kj - Q >= 0)
    s = jnp.einsum('bhrnqd,bhrnkd->bhrnqk', qb, kw).astype(jnp.float32) * (D ** -0.5)
    s = jnp.where(mask, s, NEG_INF)
    m = jnp.max(s, axis=-1, keepdims=True)
    p = jnp.exp(s - m)
    den = jnp.sum(p, axis=-1, keepdims=True)
    o = jnp.einsum('bhrnqk,bhrnkd->bhrnqd', p / den, vw.astype(jnp.float32))
    lse = (m + jnp.log(den))[..., 0]
    o = o.reshape(B, H, dilation, Lp, D)[:, :, :, :L].transpose(0, 1, 3, 2, 4).reshape(B, H, S, D)
    lse = lse.reshape(B, H, dilation, Lp)[:, :, :, :L].transpose(0, 1, 3, 2).reshape(B, H, S)
    return o, lse


def dilated_mixture(q, k, v):
    outs, lses = zip(*[dilated_branch(q, k, v, w, d) for (w, d) in DILATED_BRANCHES])
    wts = jax.nn.softmax(jnp.stack(lses, axis=0), axis=0)
    return jnp.sum(wts[..., None] * jnp.stack(outs, axis=0), axis=0).astype(q.dtype)


def moba_attention(q, k, v):
    B, H, S, D = q.shape
    T = MOBA_BLOCK
    nb = -(-S // T)
    Sp = nb * T
    pad = ((0, 0), (0, 0), (0, Sp - S), (0, 0))
    kp, vp = jnp.pad(k, pad), jnp.pad(v, pad)
    kb, vb = kp.reshape(B, H, nb, T, D), vp.reshape(B, H, nb, T, D)
    k_mean = jnp.mean(kb.astype(jnp.float32), axis=3)
    q_blk = jnp.arange(S) // T
    past = jnp.arange(nb)[None, :] < q_blk[:, None]
    gate = jnp.einsum('bhsd,bhnd->bhsn', q.astype(jnp.float32), k_mean)
    gate = jnp.where(past, gate, NEG_INF)
    top = min(MOBA_TOPK, nb)
    _, sel = lax.top_k(gate, top)
    sel_ok = sel < q_blk[:, None]
    C = MOBA_Q_CHUNK
    nq = S // C

    def chunks(t):
        return jnp.moveaxis(t.reshape(B, H, nq, C, *t.shape[3:]), 2, 0)

    bi = jnp.arange(B)[:, None, None, None]
    hi = jnp.arange(H)[None, :, None, None]
    scale = D ** -0.5

    def step(args):
        qc, sc, okc, c = args
        k_sel = kb[bi, hi, sc]
        v_sel = vb[bi, hi, sc]
        own = (c * C) // T
        k_own = lax.dynamic_slice_in_dim(kp, own * T, T, axis=2)
        v_own = lax.dynamic_slice_in_dim(vp, own * T, T, axis=2)
        s_sel = jnp.einsum('bhqd,bhqjtd->bhqjt', qc, k_sel).astype(jnp.float32) * scale
        s_sel = jnp.where(okc[..., None], s_sel, NEG_INF).reshape(B, H, C, top * T)
        qpos = c * C + jnp.arange(C)
        kpos = own * T + jnp.arange(T)
        s_own = jnp.einsum('bhqd,bhtd->bhqt', qc, k_own).astype(jnp.float32) * scale
        s_own = jnp.where(kpos[None, :] <= qpos[:, None], s_own, NEG_INF)
        p = jax.nn.softmax(jnp.concatenate([s_sel, s_own], axis=-1), axis=-1).astype(v.dtype)
        p_sel = p[..., :top * T].reshape(B, H, C, top, T)
        p_own = p[..., top * T:]
        return (jnp.einsum('bhqjt,bhqjtd->bhqd', p_sel, v_sel)
                + jnp.einsum('bhqt,bhtd->bhqd', p_own, v_own))

    o = lax.map(step, (chunks(q), chunks(sel), chunks(sel_ok), jnp.arange(nq)))
    return jnp.moveaxis(o, 0, 2).reshape(B, H, S, D)


def even_mixer(h, w_in, w_out):
    B, S, _ = h.shape
    qa, ka, va, qb, kb, vb = jnp.split(
        h @ w_in, [WIDTH_A, 2 * WIDTH_A, 3 * WIDTH_A, 3 * WIDTH_A + WIDTH_B, 3 * WIDTH_A + 2 * WIDTH_B], axis=-1)

    def heads(t, n):
        return t.reshape(B, S, n, HEAD_DIM).transpose(0, 2, 1, 3)

    o_a = dilated_mixture(rope(heads(qa, N_HEADS_A)), rope(heads(ka, N_HEADS_A)), heads(va, N_HEADS_A))
    o_b = moba_attention(rope(heads(qb, N_HEADS_B)), rope(heads(kb, N_HEADS_B)), heads(vb, N_HEADS_B))
    o = jnp.concatenate([o_a, o_b.astype(o_a.dtype)], axis=1)
    return o.transpose(0, 2, 1, 3).reshape(B, S, WIDTH_A + WIDTH_B) @ w_out


def diff_attention(q1, q2, k1, k2, v, lam):
    B, H, S, d = q1.shape
    Q = DENSE_Q_BLOCK
    nq = S // Q
    kpos = jnp.arange(S)
    scale = d ** -0.5

    def blocks(t):
        return jnp.moveaxis(t.reshape(B, H, nq, Q, d), 2, 0)

    def step(args):
        a, b, c = args
        qpos = c * Q + jnp.arange(Q)
        mask = kpos[None, :] <= qpos[:, None]
        s1 = jnp.where(mask, jnp.einsum('bhqd,bhkd->bhqk', a, k1).astype(jnp.float32) * scale, NEG_INF)
        s2 = jnp.where(mask, jnp.einsum('bhqd,bhkd->bhqk', b, k2).astype(jnp.float32) * scale, NEG_INF)
        w = jax.nn.softmax(s1, axis=-1) - lam * jax.nn.softmax(s2, axis=-1)
        return jnp.einsum('bhqk,bhke->bhqe', w.astype(v.dtype), v)

    o = lax.map(step, (blocks(q1), blocks(q2), jnp.arange(nq)))
    return jnp.moveaxis(o, 0, 2).reshape(B, H, S, 2 * d)


def diff_mixer(h, w_in, w_out, lq1, lk1, lq2, lk2, subln_g, lambda_init):
    B, S, _ = h.shape
    H, d = N_HEADS_C, HEAD_DIM
    q, k, v = jnp.split(h @ w_in, 3, axis=-1)
    q = rope(q.reshape(B, S, H, 2, d).transpose(0, 2, 3, 1, 4))
    k = rope(k.reshape(B, S, H, 2, d).transpose(0, 2, 3, 1, 4))
    v = v.reshape(B, S, H, 2 * d).transpose(0, 2, 1, 3)
    f32 = jnp.float32
    lam = (jnp.exp(jnp.sum(lq1.astype(f32) * lk1.astype(f32)))
           - jnp.exp(jnp.sum(lq2.astype(f32) * lk2.astype(f32))) + lambda_init)
    o = diff_attention(q[:, :, 0], q[:, :, 1], k[:, :, 0], k[:, :, 1], v, lam)
    o = rmsnorm(o, subln_g, SUBLN_EPS) * (1.0 - lambda_init)
    return o.transpose(0, 2, 1, 3).reshape(B, S, H * 2 * d) @ w_out


def lambda_init_fn(layer):
    return 0.8 - 0.6 * math.exp(-0.3 * layer)


def setup_inputs(seed: int = 0) -> dict:
    key = jax.random.key(seed)
    ks = iter(jax.random.split(key, 24))

    def nrm(shape, fan_in):
        return jax.random.normal(next(ks), shape, jnp.float32) * fan_in ** -0.5

    def gain(shape):
        return 1.0 + 0.02 * jax.random.normal(next(ks), shape, jnp.float32)

    def small(shape):
        return 0.1 * jax.random.normal(next(ks), shape, jnp.float32)

    w_even = 3 * (WIDTH_A + WIDTH_B)
    w_odd = 3 * N_HEADS_C * 2 * HEAD_DIM
    return {
        "x": jax.random.normal(next(ks), (BATCH, SEQ, D_MODEL), jnp.float32),
        "ffa_norm": gain((DEPTH, D_MODEL)),
        "ffa_w_in": nrm((DEPTH, D_MODEL, 2 * D_FF), D_MODEL),
        "ffa_w_out": nrm((DEPTH, D_FF, D_MODEL), D_FF),
        "mix_norm": gain((DEPTH, D_MODEL)),
        "even_w_in": nrm((N_EVEN, D_MODEL, w_even), D_MODEL),
        "even_w_out": nrm((N_EVEN, WIDTH_A + WIDTH_B, D_MODEL), WIDTH_A + WIDTH_B),
        "odd_w_in": nrm((N_ODD, D_MODEL, w_odd), D_MODEL),
        "odd_w_out": nrm((N_ODD, N_HEADS_C * 2 * HEAD_DIM, D_MODEL), N_HEADS_C * 2 * HEAD_DIM),
        "lambda_q1": small((N_ODD, HEAD_DIM)),
        "lambda_k1": small((N_ODD, HEAD_DIM)),
        "lambda_q2": small((N_ODD, HEAD_DIM)),
        "lambda_k2": small((N_ODD, HEAD_DIM)),
        "subln_norm": gain((N_ODD, 2 * HEAD_DIM)),
        "ffb_norm": gain((DEPTH, D_MODEL)),
        "ffb_w_in": nrm((DEPTH, D_MODEL, 2 * D_FF), D_MODEL),
        "ffb_w_out": nrm((DEPTH, D_FF, D_MODEL), D_FF),
        "final_norm": gain((D_MODEL,)),
    }


def reference(x, ffa_norm, ffa_w_in, ffa_w_out, mix_norm, even_w_in, even_w_out, odd_w_in, odd_w_out,
              lambda_q1, lambda_k1, lambda_q2, lambda_k2, subln_norm, ffb_norm, ffb_w_in, ffb_w_out,
              final_norm):
    h = x
    for l in range(DEPTH):
        i = l // 2
        h = h + 0.5 * swiglu(rmsnorm(h, ffa_norm[l]), ffa_w_in[l], ffa_w_out[l])
        hn = rmsnorm(h, mix_norm[l])
        if l % 2 == 0:
            h = h + even_mixer(hn, even_w_in[i], even_w_out[i])
        else:
            h = h + diff_mixer(hn, odd_w_in[i], odd_w_out[i], lambda_q1[i], lambda_k1[i],
                               lambda_q2[i], lambda_k2[i], subln_norm[i], lambda_init_fn(l))
        h = h + 0.5 * swiglu(rmsnorm(h, ffb_norm[l]), ffb_w_in[l], ffb_w_out[l])
    return rmsnorm(h, final_norm)
```

```cpp
#include <hip/hip_runtime.h>
#include <hip/hip_cooperative_groups.h>
#include <cstdio>
#include <cstdint>
namespace cg = cooperative_groups;
namespace pg8 {
#define PG8_LAS __attribute__((address_space(3)))
typedef unsigned short bf16_t;
typedef short bf16x8 __attribute__((ext_vector_type(8)));
typedef float f32x4 __attribute__((ext_vector_type(4)));
typedef unsigned u32x4 __attribute__((ext_vector_type(4)));
constexpr int BM = 256, BK = 64, HALF = 128, HTB = HALF * BK * 2  , STAGE_BYTES = 8 * HTB, NXCD = 8, WGM = 8;

__host__ __device__ __forceinline__ int lds_byte(int r, int c) { const int st = (r >> 4) * 2 + (c >> 5), rr = r & 15, cc = c & 31, ob = rr * 64 + cc * 2; return st * 1024 + (ob ^ (((ob >> 9) & 1) << 5)); }
__host__ __device__ __forceinline__ void stage_rc(int b, int& R, int& C) { const int st = b / 1024, sb = b % 1024, swz = sb ^ (((sb >> 9) & 1) << 5); R = (st >> 1) * 16 + swz / 64; C = (st & 1) * 32 + (swz % 64) / 2; }
__host__ __device__ __forceinline__ int perm32(int rho) { const int n = rho >> 4, i = rho & 15; return 8 * (i >> 2) + 4 * n + (i & 3); }

struct Unit { int pm, pn; };
struct Gemm { const bf16_t* A; const bf16_t* Bt; int M, N, K; };

struct StaticOrder {
    int nM, nN, nwg, G, c;
    __host__ __device__ void init(int M, int N, int G_, int c_) { nM = M / BM; nN = N / BM; nwg = nM * nN; G = G_; c = c_; }
    __host__ __device__ bool next(int i, Unit& u) const {
        const long L = (long)i * G + c; if (L >= nwg) return false;
        int wgid = (int)L; { const int q = nwg / NXCD, r = nwg % NXCD, xcd = wgid % NXCD, off = wgid / NXCD; wgid = (xcd < r ? xcd * (q + 1) : r * (q + 1) + (xcd - r) * q) + off; }
        const int nig = WGM * nN, gid = wgid / nig, fm = gid * WGM, gsz = (nM - fm) < WGM ? (nM - fm) : WGM;
        u.pm = fm + ((wgid % nig) % gsz); u.pn = (wgid % nig) / gsz; return true;
    }
    __device__ __forceinline__ void a_ready(const Unit&) const {}
    __device__ __forceinline__ void done(const Unit&) const {}
};

__device__ __forceinline__ unsigned cvt_pk_bf16(float lo, float hi) { unsigned r; asm volatile("v_cvt_pk_bf16_f32 %0, %1, %2" : "=v"(r) : "v"(lo), "v"(hi)); return r; }
typedef float f32x2 __attribute__((ext_vector_type(2)));
struct EpiSwiGLU {
    static constexpr bool PERM = true, AFTER_DRAIN = false;
    bf16_t* O; int ldc;
    __device__ __forceinline__ void operator()(const f32x4 (&acc)[2][2][4][2], const Unit& u, int wr, int wc, int fr, int fq) const {
        const int row0 = u.pm * BM + wr * 64 + fr, col0 = u.pn * HALF + wc * 32 + 8 * fq;
#pragma unroll
        for (int ai = 0; ai < 2; ++ai)
#pragma unroll
            for (int m = 0; m < 4; ++m) {
                bf16_t* rowp = O + (size_t)(row0 + ai * HALF + m * 16) * ldc + col0;
                float h[8];
#pragma unroll
                for (int n = 0; n < 2; ++n)
#pragma unroll
                    for (int e = 0; e < 4; ++e) { const float g = acc[ai][0][m][n][e], up = acc[ai][1][m][n][e];
                        const float sg = __builtin_amdgcn_rcpf(1.0f + __builtin_amdgcn_exp2f(-1.4426950408889634f * g)); h[n * 4 + e] = g * sg * up; }
                u32x4 w; w.x = cvt_pk_bf16(h[0], h[1]); w.y = cvt_pk_bf16(h[2], h[3]); w.z = cvt_pk_bf16(h[4], h[5]); w.w = cvt_pk_bf16(h[6], h[7]);
                *(u32x4*)rowp = w;
            }
    }
};
struct EpiResid {
    static constexpr bool PERM = true, AFTER_DRAIN = false;
    const float* base; float* out; int ldc; float scale;
    __device__ __forceinline__ void operator()(const f32x4 (&acc)[2][2][4][2], const Unit& u, int wr, int wc, int fr, int fq) const {
        const int row0 = u.pm * BM + wr * 64 + fr, col0 = u.pn * BM + wc * 32 + 8 * fq;
#pragma unroll
        for (int ai = 0; ai < 2; ++ai)
#pragma unroll
            for (int m = 0; m < 4; ++m)
#pragma unroll
                for (int bj = 0; bj < 2; ++bj) {
                    const size_t p = (size_t)(row0 + ai * HALF + m * 16) * ldc + col0 + bj * HALF;
                    const f32x4 b0 = *(const f32x4*)(base + p), b1 = *(const f32x4*)(base + p + 4);
                    *(f32x4*)(out + p) = b0 + acc[ai][bj][m][0] * scale; *(f32x4*)(out + p + 4) = b1 + acc[ai][bj][m][1] * scale;
                }
    }
};
struct EpiQKV {
    static constexpr bool PERM = true, AFTER_DRAIN = false;
    bf16_t* O; int ldc; const float* cosT; const float* sinT; unsigned long long ropemask;
    __device__ __forceinline__ void operator()(const f32x4 (&acc)[2][2][4][2], const Unit& u, int wr, int wc, int fr, int fq) const {
        const int row0 = u.pm * BM + wr * 64 + fr, col0 = u.pn * BM + wc * 32 + 8 * fq, j0 = 16 * wc + 4 * fq;
#pragma unroll
        for (int ai = 0; ai < 2; ++ai)
#pragma unroll
            for (int m = 0; m < 4; ++m) {
                const int row = row0 + ai * HALF + m * 16, pos = row & 8191;
                const f32x4 cs = *(const f32x4*)(cosT + pos * 64 + j0), sn = *(const f32x4*)(sinT + pos * 64 + j0);
#pragma unroll
                for (int bj = 0; bj < 2; ++bj) {
                    const bool roped = (ropemask >> (u.pn * 2 + bj)) & 1ull;
                    f32x4 v0 = acc[ai][bj][m][0], v1 = acc[ai][bj][m][1];
                    if (roped) {
                        const f32x4 a = v0, b = v1;
                        v0[0] = a[0] * cs[0] - a[1] * sn[0]; v0[1] = a[1] * cs[0] + a[0] * sn[0];
                        v0[2] = a[2] * cs[1] - a[3] * sn[1]; v0[3] = a[3] * cs[1] + a[2] * sn[1];
                        v1[0] = b[0] * cs[2] - b[1] * sn[2]; v1[1] = b[1] * cs[2] + b[0] * sn[2];
                        v1[2] = b[2] * cs[3] - b[3] * sn[3]; v1[3] = b[3] * cs[3] + b[2] * sn[3];
                    }
                    u32x4 w; w.x = cvt_pk_bf16(v0[0], v0[1]); w.y = cvt_pk_bf16(v0[2], v0[3]); w.z = cvt_pk_bf16(v1[0], v1[1]); w.w = cvt_pk_bf16(v1[2], v1[3]);
                    *(u32x4*)(O + (size_t)row * ldc + col0 + bj * HALF) = w;
                }
            }
    }
};
template <class Epi, class Sched, bool ALIGN_EPI = false, bool SP2 = false>
__device__ __forceinline__ void gemm_phase(PG8_LAS unsigned char* lds, const Gemm g, const Sched& S, const Epi& E, const int wave_s  ) {
    int tid_; asm volatile("v_mbcnt_lo_u32_b32 %0, -1, 0\n\tv_mbcnt_hi_u32_b32 %0, -1, %0" : "=v"(tid_)); tid_ += wave_s * 64;
    const int tid = tid_, wid = __builtin_amdgcn_readfirstlane(tid >> 6), lane = tid & 63, wr = wid >> 2, wc = wid & 3, fr = lane & 15, fq = lane >> 4;
    const int K = g.K, nt = K / BK;
    unsigned voffA[2], voffB[2];
#pragma unroll
    for (int i = 0; i < 2; ++i) { int R, C; stage_rc(tid * 16 + i * 8192, R, C); const int Rb = Epi::PERM ? ((R & ~31) + perm32(R & 31)) : R;
        voffA[i] = (unsigned)(R * K + C) * 2u; voffB[i] = (unsigned)(Rb * K + C) * 2u; }
    const size_t kstep = (size_t)(BK * 2);
    const size_t hstep = (size_t)HALF * K * 2;
    const size_t tstep = 2 * hstep;
    const unsigned ldsw = (unsigned)wid * 1024u;
    const int aoff = lds_byte(wr * 64 + fr, fq * 8), boff = lds_byte(wc * 32 + fr, fq * 8);
#define PG8_SA(b, h) (((b) * 2 + (h)) * HTB)
#define PG8_SB(b, h) ((4 + (b) * 2 + (h)) * HTB)
#define PG8_STAGE(bufoff, gbase, voff) do { _Pragma("unroll") for (int _i = 0; _i < 2; ++_i) \
        __builtin_amdgcn_global_load_lds((const unsigned*)((const char*)(gbase) + (voff)[_i]), (PG8_LAS unsigned*)(lds + (bufoff) + ldsw + _i * 8192), 16, 0, 0); } while (0)
#define PG8_LDA(dst, b, h) do { _Pragma("unroll") for (int m = 0; m < 4; ++m) _Pragma("unroll") for (int k = 0; k < 2; ++k) dst[m][k] = *(const PG8_LAS bf16x8*)(lds + PG8_SA(b, h) + aoff + m * 2048 + k * 1024); } while (0)
#define PG8_LDB(dst, b, h) do { _Pragma("unroll") for (int n = 0; n < 2; ++n) _Pragma("unroll") for (int k = 0; k < 2; ++k) dst[n][k] = *(const PG8_LAS bf16x8*)(lds + PG8_SB(b, h) + boff + n * 2048 + k * 1024); } while (0)
#define PG8_MMA(ai, bj, At, Bt) do { __builtin_amdgcn_s_setprio(1); _Pragma("unroll") for (int m = 0; m < 4; ++m) _Pragma("unroll") for (int n = 0; n < 2; ++n) _Pragma("unroll") for (int k = 0; k < 2; ++k) \
        acc[ai][bj][m][n] = __builtin_amdgcn_mfma_f32_16x16x32_bf16(Bt[n][k], At[m][k], acc[ai][bj][m][n], 0, 0, 0); __builtin_amdgcn_s_setprio(0); } while (0)
#define PG8_WAIT_V(n) asm volatile("s_waitcnt vmcnt(" #n ")" ::: "memory")
#define PG8_WAIT_L(n) asm volatile("s_waitcnt lgkmcnt(" #n ")" ::: "memory")
#define PG8_BAR __builtin_amdgcn_s_barrier()
#define PG8_SCHED __builtin_amdgcn_sched_barrier(0)
    Unit cur, nxt; int ui = 0;
    if (!S.next(0, cur)) return;
    f32x4 acc[2][2][4][2];
#pragma unroll
    for (int a = 0; a < 2; ++a)
#pragma unroll
        for (int b = 0; b < 2; ++b)
#pragma unroll
            for (int m = 0; m < 4; ++m)
#pragma unroll
                for (int n = 0; n < 2; ++n) acc[a][b][m][n] = (f32x4){0.f, 0.f, 0.f, 0.f};
    bf16x8 At[4][2], B0[2][2], B1[2][2];
    const char* cA = (const char*)g.A + (size_t)cur.pm * tstep; const char* cB = (const char*)g.Bt + (size_t)cur.pn * tstep;
    S.a_ready(cur);
    if constexpr (SP2) {
        PG8_STAGE(PG8_SB(0, 0), cB, voffB); PG8_STAGE(PG8_SB(0, 1), cB + hstep, voffB); PG8_STAGE(PG8_SA(0, 0), cA, voffA); PG8_STAGE(PG8_SA(0, 1), cA + hstep, voffA);
        if (wr == 1) PG8_BAR;
        PG8_WAIT_V(2); PG8_BAR;
        PG8_STAGE(PG8_SB(1, 0), cB + kstep, voffB); PG8_STAGE(PG8_SA(1, 0), cA + kstep, voffA); PG8_STAGE(PG8_SB(1, 1), cB + hstep + kstep, voffB);
        PG8_WAIT_V(6); PG8_BAR;
    } else {
        PG8_STAGE(PG8_SB(0, 0), cB, voffB); PG8_STAGE(PG8_SA(0, 0), cA, voffA); PG8_STAGE(PG8_SB(0, 1), cB + hstep, voffB); PG8_STAGE(PG8_SA(0, 1), cA + hstep, voffA);
        if (wr == 1) PG8_BAR;
        PG8_WAIT_V(4); PG8_BAR;
        PG8_STAGE(PG8_SB(1, 0), cB + kstep, voffB); PG8_STAGE(PG8_SA(1, 0), cA + kstep, voffA); PG8_STAGE(PG8_SB(1, 1), cB + hstep + kstep, voffB);
        PG8_WAIT_V(6); PG8_BAR;
    }
    for (;;) {
        const bool has_next = S.next(ui + 1, nxt);
        const char* nA = has_next ? (const char*)g.A + (size_t)nxt.pm * tstep : cA; const char* nB = has_next ? (const char*)g.Bt + (size_t)nxt.pn * tstep : cB;
        for (int t = 0; t < nt; t += 2) {
            const bool last = (t == nt - 2);
            const char* a1 = cA + (size_t)(t + 1) * kstep;
            const char* a2 = last ? nA : cA + (size_t)(t + 2) * kstep; const char* b2 = last ? nB : cB + (size_t)(t + 2) * kstep;
            const char* a3 = a2 + kstep; const char* b3 = b2 + kstep;
            if (last && has_next) S.a_ready(nxt);
            if constexpr (SP2) {
            PG8_LDB(B0, 0, 0); PG8_LDB(B1, 0, 1); PG8_SCHED; PG8_LDA(At, 0, 0); PG8_STAGE(PG8_SA(1, 1), a1 + hstep, voffA);
            PG8_WAIT_V(8); PG8_WAIT_L(0); PG8_BAR; PG8_MMA(0, 0, At, B0); PG8_MMA(0, 1, At, B1); PG8_BAR; PG8_SCHED;
            PG8_LDA(At, 0, 1); PG8_STAGE(PG8_SB(0, 0), b2, voffB); PG8_STAGE(PG8_SB(0, 1), b2 + hstep, voffB); PG8_STAGE(PG8_SA(0, 0), a2, voffA);
            PG8_WAIT_V(8); PG8_WAIT_L(0); PG8_BAR; PG8_MMA(1, 0, At, B0); PG8_MMA(1, 1, At, B1); PG8_BAR; PG8_SCHED;
            PG8_LDB(B0, 1, 0); PG8_LDB(B1, 1, 1); PG8_SCHED; PG8_LDA(At, 1, 0); PG8_STAGE(PG8_SA(0, 1), a2 + hstep, voffA);
            PG8_WAIT_V(8); PG8_WAIT_L(0); PG8_BAR; PG8_MMA(0, 0, At, B0); PG8_MMA(0, 1, At, B1); PG8_BAR; PG8_SCHED;
            PG8_LDA(At, 1, 1); PG8_STAGE(PG8_SB(1, 0), b3, voffB); PG8_STAGE(PG8_SB(1, 1), b3 + hstep, voffB); PG8_STAGE(PG8_SA(1, 0), a3, voffA);
            PG8_WAIT_V(8); PG8_WAIT_L(0); PG8_BAR; PG8_MMA(1, 0, At, B0); PG8_MMA(1, 1, At, B1); PG8_BAR; PG8_SCHED;
            } else {
            PG8_LDB(B0, 0, 0); PG8_SCHED; PG8_LDA(At, 0, 0); PG8_STAGE(PG8_SA(1, 1), a1 + hstep, voffA);
            PG8_WAIT_L(8); PG8_BAR; PG8_WAIT_L(0); PG8_MMA(0, 0, At, B0); PG8_BAR; PG8_SCHED;
            PG8_LDB(B1, 0, 1); PG8_STAGE(PG8_SB(0, 0), b2, voffB);
            PG8_BAR; PG8_WAIT_L(0); PG8_MMA(0, 1, At, B1); PG8_BAR;
            PG8_LDA(At, 0, 1); PG8_STAGE(PG8_SA(0, 0), a2, voffA);
            PG8_BAR; PG8_WAIT_L(0); PG8_MMA(1, 0, At, B0); PG8_BAR; PG8_SCHED;
            PG8_STAGE(PG8_SB(0, 1), b2 + hstep, voffB);
            PG8_WAIT_V(6); PG8_BAR; PG8_MMA(1, 1, At, B1); PG8_BAR;
            PG8_LDB(B0, 1, 0); PG8_SCHED; PG8_LDA(At, 1, 0); PG8_STAGE(PG8_SA(0, 1), a2 + hstep, voffA);
            PG8_WAIT_L(8); PG8_BAR; PG8_WAIT_L(0); PG8_MMA(0, 0, At, B0); PG8_BAR; PG8_SCHED;
            PG8_LDB(B1, 1, 1); PG8_STAGE(PG8_SB(1, 0), b3, voffB);
            PG8_BAR; PG8_WAIT_L(0); PG8_MMA(0, 1, At, B1); PG8_BAR;
            PG8_LDA(At, 1, 1); PG8_STAGE(PG8_SA(1, 0), a3, voffA);
            PG8_BAR; PG8_WAIT_L(0); PG8_MMA(1, 0, At, B0); PG8_BAR; PG8_SCHED;
            PG8_STAGE(PG8_SB(1, 1), b3 + hstep, voffB);
            PG8_WAIT_V(6); PG8_BAR; PG8_MMA(1, 1, At, B1); PG8_BAR;
            }
        }
        if constexpr (ALIGN_EPI) { if (wr == 0) PG8_BAR; }
        if constexpr (!Epi::AFTER_DRAIN) { E(acc, cur, wr, wc, fr, fq); S.done(cur); }
        if (!has_next) break;
#pragma unroll
        for (int a = 0; a < 2; ++a)
#pragma unroll
            for (int b = 0; b < 2; ++b)
#pragma unroll
                for (int m = 0; m < 4; ++m)
#pragma unroll
                    for (int n = 0; n < 2; ++n) acc[a][b][m][n] = (f32x4){0.f, 0.f, 0.f, 0.f};
        cur = nxt; cA = nA; cB = nB; ++ui;
        if constexpr (ALIGN_EPI) { if (wr == 1) PG8_BAR; }
    }
    PG8_WAIT_V(0);
    if constexpr (!ALIGN_EPI) { if (wr == 0) PG8_BAR; }
    PG8_BAR;
    if constexpr (Epi::AFTER_DRAIN) { E.fused(acc, cur, wr, wc, fr, fq, lds, wid, lane); S.done(cur); }
#undef PG8_SA
#undef PG8_SB
#undef PG8_STAGE
#undef PG8_LDA
#undef PG8_LDB
#undef PG8_MMA
#undef PG8_WAIT_V
#undef PG8_WAIT_L
#undef PG8_BAR
#undef PG8_SCHED
}
}

#define LAS __attribute__((address_space(3)))
typedef unsigned short bf16_t;
typedef short bf16x8 __attribute__((ext_vector_type(8)));
typedef short s16x4 __attribute__((ext_vector_type(4)));
typedef float f32x4 __attribute__((ext_vector_type(4)));
typedef float f32x16 __attribute__((ext_vector_type(16)));
typedef unsigned u32x4 __attribute__((ext_vector_type(4)));
typedef unsigned u32x2 __attribute__((ext_vector_type(2)));

constexpr int SEQ = 8192, DM = 2048, MTOK = 16384, DFF = 5632, NQKV = 6144, HD = 128;
constexpr size_t SZ_WIN = (size_t)2 * DFF * DM * 2, SZ_WOUT = (size_t)DM * DFF * 2, SZ_WMIN = (size_t)NQKV * DM * 2, SZ_WMOUT = (size_t)DM * DM * 2;
constexpr size_t WS_FFA_IN = 0, WS_FFA_OUT = WS_FFA_IN + 2 * SZ_WIN, WS_FFB_IN = WS_FFA_OUT + 2 * SZ_WOUT, WS_FFB_OUT = WS_FFB_IN + 2 * SZ_WIN;
constexpr size_t WS_MIX_IN = WS_FFB_OUT + 2 * SZ_WOUT, WS_MIX_OUT = WS_MIX_IN + 2 * SZ_WMIN;
constexpr size_t WS_XN = WS_MIX_OUT + 2 * SZ_WMOUT;
constexpr size_t WS_BIG = WS_XN + (size_t)MTOK * DM * 2;
constexpr size_t WS_ATT = WS_BIG + (size_t)MTOK * NQKV * 2;
constexpr size_t WS_PART = WS_ATT + (size_t)MTOK * DM * 2;
constexpr size_t WS_LSE = WS_PART + (size_t)3 * MTOK * 1024 * 2;
constexpr size_t WS_ROPE = WS_LSE + (size_t)3 * MTOK * 8 * 4;
constexpr size_t WS_KMEAN = WS_ROPE + (size_t)2 * SEQ * 64 * 4;
constexpr size_t WS_CTL = WS_KMEAN + (size_t)2 * 8 * 32 * 128 * 4, CTL_BYTES = 16384;
constexpr size_t WS_END = WS_CTL + CTL_BYTES;

#ifndef REP_ATT
#define REP_ATT 1
#endif
#ifndef REP_DIL
#define REP_DIL REP_ATT
#endif
#ifndef REP_MOBA
#define REP_MOBA REP_ATT
#endif
#ifndef REP_DIFF
#define REP_DIFF REP_ATT
#endif
#ifndef REP_PRO
#define REP_PRO 1
#endif
#ifndef REP_SWI
#define REP_SWI 1
#endif
#ifndef REP_QKV
#define REP_QKV 1
#endif
#ifndef REP_NORM
#define REP_NORM 1
#endif
#ifndef REP_RES
#define REP_RES 1
#endif
#ifndef REP_SYNC
#define REP_SYNC 1
#endif
#define GSYNC() do { for (int rs_ = 0; rs_ < REP_SYNC; ++rs_) { int l_; asm volatile("v_mbcnt_lo_u32_b32 %0, -1, 0\n\tv_mbcnt_hi_u32_b32 %0, -1, %0" : "=v"(l_)); xcd_barrier(xbar, (l_ + wave_s * 64) == 0); } } while (0)
constexpr int LDS_BYTES = 135168;

struct Params {
    const float* in[18];
    float* out; unsigned char* ws;
};

__device__ __forceinline__ unsigned f2bf(float f) { unsigned u = __builtin_bit_cast(unsigned, f); return (u + 0x7fffu + ((u >> 16) & 1u)) >> 16; }
__device__ __forceinline__ unsigned pk2(float lo, float hi) { return f2bf(lo) | (f2bf(hi) << 16); }
__device__ __forceinline__ float bf2f(unsigned short b) { return __builtin_bit_cast(float, (unsigned)b << 16); }
__device__ __forceinline__ int shfl_xor_i(int v, int o, int lane) { return __builtin_amdgcn_ds_bpermute((lane ^ o) << 2, v); }
__device__ __forceinline__ float shfl_xor_f(float v, int o, int lane) { return __int_as_float(__builtin_amdgcn_ds_bpermute((lane ^ o) << 2, __float_as_int(v))); }
__device__ __forceinline__ float wave_sum(float v, int lane) {
#pragma unroll
    for (int o = 1; o < 64; o <<= 1) v += shfl_xor_f(v, o, lane);
    return v;
}

template <int MODE>
__device__ __forceinline__ int src_col(int n, unsigned long long ropemask) {
    if (MODE == 0) return n;
    if (MODE == 1) { const int pn = n >> 8, cc = n & 255; return cc < 128 ? pn * 128 + cc : DFF + pn * 128 + (cc - 128); }
    const int hg = n >> 7, p = n & 127;
    if ((ropemask >> hg) & 1ull) return hg * 128 + ((p & 1) ? 64 + (p >> 1) : (p >> 1));
    return n;
}
template <int MODE>
__device__ __forceinline__ void transpose_items(const float* W, int K, int N, bf16_t* WT, unsigned long long ropemask, LAS float* scr, int gw, int NGW, int lane) {
    const int nblk = N / 32, nitems = (K / 64) * nblk;
    for (int item = gw; item < nitems; item += NGW) {
        const int kb = item / nblk, nb = item % nblk, k0 = 64 * kb, n0 = 32 * nb;
        const int sc = src_col<MODE>(n0 + (lane & 31), ropemask);
#pragma unroll
        for (int i = 0; i < 32; ++i) { const int kk = 2 * i + (lane >> 5); scr[kk * 33 + (lane & 31)] = W[(size_t)(k0 + kk) * N + sc]; }
        asm volatile("s_waitcnt lgkmcnt(0)" ::: "memory");
        const int c = lane & 7;
#pragma unroll
        for (int j = 0; j < 4; ++j) { const int n = (lane >> 3) + 8 * j; const LAS float* s = scr + (8 * c) * 33 + n;
            u32x4 o; o.x = pk2(s[0 * 33], s[1 * 33]); o.y = pk2(s[2 * 33], s[3 * 33]); o.z = pk2(s[4 * 33], s[5 * 33]); o.w = pk2(s[6 * 33], s[7 * 33]);
            *(u32x4*)(WT + (size_t)(n0 + n) * K + k0 + 8 * c) = o; }
        asm volatile("s_waitcnt lgkmcnt(0)" ::: "memory");
    }
}

template <bool OUT_F32>
__device__ __forceinline__ void norm_phase(const float* src, const float* gain, void* dst, int gw, int NGW, int lane) {
    f32x4 g[8];
#pragma unroll
    for (int j = 0; j < 8; ++j) g[j] = ((const f32x4*)gain)[lane + 64 * j];
    for (int row = gw; row < MTOK; row += 2 * NGW) {
        const f32x4* xr0 = (const f32x4*)(src + (size_t)row * DM) + lane;
        const int rowb = (row + NGW < MTOK) ? row + NGW : row;
        const f32x4* xr1 = (const f32x4*)(src + (size_t)rowb * DM) + lane;
        f32x4 v0[8], v1[8]; float s0 = 0.f, s1 = 0.f;
#pragma unroll
        for (int j = 0; j < 8; ++j) { v0[j] = xr0[64 * j]; v1[j] = xr1[64 * j]; }
#pragma unroll
        for (int j = 0; j < 8; ++j) { s0 += (v0[j].x * v0[j].x + v0[j].y * v0[j].y) + (v0[j].z * v0[j].z + v0[j].w * v0[j].w); s1 += (v1[j].x * v1[j].x + v1[j].y * v1[j].y) + (v1[j].z * v1[j].z + v1[j].w * v1[j].w); }
        const float r0 = 1.0f / sqrtf(wave_sum(s0, lane) * (1.0f / DM) + 1e-6f), r1 = 1.0f / sqrtf(wave_sum(s1, lane) * (1.0f / DM) + 1e-6f);
        if (OUT_F32) { f32x4* o0 = (f32x4*)((float*)dst + (size_t)row * DM) + lane; f32x4* o1 = (f32x4*)((float*)dst + (size_t)rowb * DM) + lane;
#pragma unroll
            for (int j = 0; j < 8; ++j) { o0[64 * j] = v0[j] * r0 * g[j]; o1[64 * j] = v1[j] * r1 * g[j]; }
        } else { u32x2* o0 = (u32x2*)((bf16_t*)dst + (size_t)row * DM) + lane; u32x2* o1 = (u32x2*)((bf16_t*)dst + (size_t)rowb * DM) + lane;
#pragma unroll
            for (int j = 0; j < 8; ++j) { const f32x4 y0 = v0[j] * r0 * g[j], y1 = v1[j] * r1 * g[j]; u32x2 w0, w1; w0.x = pk2(y0.x, y0.y); w0.y = pk2(y0.z, y0.w); w1.x = pk2(y1.x, y1.y); w1.y = pk2(y1.z, y1.w); o0[64 * j] = w0; o1[64 * j] = w1; } }
    }
}

namespace att {
constexpr int KSTR = 272, VSTR = 320, KBYTES = 64 * KSTR, VBYTES = 64 * VSTR;
constexpr float SC = 0.08838834764831845f * 1.4426950408889634f;
constexpr float NEG = -1e30f;
constexpr float NEGR = -1e6f;
__device__ __forceinline__ int crow(int e, int hi) { return (e & 3) + 8 * (e >> 2) + 4 * hi; }
typedef float f32x2_t __attribute__((ext_vector_type(2))); typedef __bf16 bf16x2_t __attribute__((ext_vector_type(2)));
__device__ __forceinline__ unsigned cvtpk(float lo, float hi) { f32x2_t v = {lo, hi}; bf16x2_t b = __builtin_convertvector(v, bf16x2_t); return __builtin_bit_cast(unsigned, b); }
__device__ __forceinline__ float xhalf_max(float v) { auto rr = __builtin_amdgcn_permlane32_swap(__float_as_uint(v), __float_as_uint(v), false, false); return fmaxf(__uint_as_float(rr[0]), __uint_as_float(rr[1])); }
__device__ __forceinline__ float xhalf_sum(float v) { auto rr = __builtin_amdgcn_permlane32_swap(__float_as_uint(v), __float_as_uint(v), false, false); return __uint_as_float(rr[0]) + __uint_as_float(rr[1]); }
__device__ __forceinline__ float max3f(float a, float b, float c) { float r; asm("v_max3_f32 %0, %1, %2, %3" : "=v"(r) : "v"(a), "v"(b), "v"(c)); return r; }
__device__ __forceinline__ float max2f(float a, float b) { float r; asm("v_max_f32_e32 %0, %1, %2" : "=v"(r) : "v"(a), "v"(b)); return r; }
__device__ __forceinline__ float fadd_s(float a, float b) { float r; asm("v_add_f32_e32 %0, %1, %2" : "=v"(r) : "v"(a), "v"(b)); return r; }
__device__ __forceinline__ bf16x8 pack8(const f32x16& s, int o) {
    u32x4 w; w.x = cvtpk(s[o + 0], s[o + 1]); w.y = cvtpk(s[o + 2], s[o + 3]); w.z = cvtpk(s[o + 4], s[o + 5]); w.w = cvtpk(s[o + 6], s[o + 7]);
    return __builtin_bit_cast(bf16x8, w);
}
__device__ __forceinline__ s16x4 vtr(const LAS unsigned char* p) { return __builtin_bit_cast(s16x4, __builtin_amdgcn_ds_read_tr16_b64_v4i16((LAS s16x4*)p)); }

__device__ __forceinline__ void load_q(bf16x8 (&qf)[8], const bf16_t* Qp, long qrow, int hi) {
    const bf16_t* p = Qp + qrow * NQKV + 8 * hi;
#pragma unroll
    for (int c = 0; c < 8; ++c) qf[c] = *(const bf16x8*)(p + 16 * c);
}

#ifndef PF_AHEAD
#define PF_AHEAD 3
#endif
struct Stage { u32x4 kreg[2], vreg[2]; };
template <class TS>
__device__ __forceinline__ void m_block(LAS unsigned char* lds, const TS& ts, int tau, int nt, const bf16x8 (&qf)[8], f32x16 (&O)[4], f32x16& s0, f32x16& s1, const bf16x8 (&P)[4], int kro, int vro) {
#pragma unroll
    for (int e = 0; e < 16; ++e) { s0[e] = 0.f; s1[e] = 0.f; }
#ifdef PROBE_MFMA2
    f32x16 dmy;
#pragma unroll
    for (int e = 0; e < 16; ++e) dmy[e] = 0.f;
#endif
    const bool qk_on = tau + 1 < nt && ts.active(tau + 1);
    const LAS unsigned char* kb = lds + ((tau + 1) & 1) * KBYTES + kro;
    bf16x8 fk[2][4];
    if (qk_on) {
#pragma unroll
        for (int j = 0; j < 2; ++j) { fk[0][2 * j] = *(const LAS bf16x8*)(kb + j * 32); fk[0][2 * j + 1] = *(const LAS bf16x8*)(kb + 32 * KSTR + j * 32); }
    }
    __builtin_amdgcn_sched_barrier(0);
    if (tau >= 0 && ts.active(tau)) {
        const LAS unsigned char* vb = lds + 2 * KBYTES + (tau & 1) * VBYTES + vro;
        s16x4 fl[2][4], fh[2][4];
#pragma unroll
        for (int b = 0; b < 4; ++b) { fl[0][b] = vtr(vb + b * 64); fh[0][b] = vtr(vb + 8 * VSTR + b * 64); }
        __builtin_amdgcn_sched_barrier(0);
#pragma unroll
        for (int q = 0; q < 4; ++q) {
            if (q < 3) {
#pragma unroll
                for (int b = 0; b < 4; ++b) { fl[(q + 1) & 1][b] = vtr(vb + (16 * (q + 1)) * VSTR + b * 64); fh[(q + 1) & 1][b] = vtr(vb + (16 * (q + 1) + 8) * VSTR + b * 64); }
            }
#pragma unroll
            for (int b = 0; b < 4; ++b) {
                const s16x4 lo = fl[q & 1][b], hh = fh[q & 1][b];
                const bf16x8 vf = (bf16x8){lo[0], lo[1], lo[2], lo[3], hh[0], hh[1], hh[2], hh[3]};
                O[b] = __builtin_amdgcn_mfma_f32_32x32x16_bf16(vf, P[q], O[b], 0, 0, 0);
#ifdef PROBE_MFMA2
                dmy = __builtin_amdgcn_mfma_f32_32x32x16_bf16(vf, P[q], dmy, 0, 0, 0);
#endif
            }
            __builtin_amdgcn_sched_barrier(0);
        }
    }
    if (qk_on) {
#pragma unroll
        for (int c2 = 0; c2 < 4; ++c2) {
            if (c2 < 3) {
#pragma unroll
                for (int j = 0; j < 2; ++j) { fk[(c2 + 1) & 1][2 * j] = *(const LAS bf16x8*)(kb + (2 * (c2 + 1) + j) * 32); fk[(c2 + 1) & 1][2 * j + 1] = *(const LAS bf16x8*)(kb + 32 * KSTR + (2 * (c2 + 1) + j) * 32); }
            }
#pragma unroll
            for (int j = 0; j < 2; ++j) {
                s0 = __builtin_amdgcn_mfma_f32_32x32x16_bf16(fk[c2 & 1][2 * j], qf[2 * c2 + j], s0, 0, 0, 0);
                s1 = __builtin_amdgcn_mfma_f32_32x32x16_bf16(fk[c2 & 1][2 * j + 1], qf[2 * c2 + j], s1, 0, 0, 0);
#ifdef PROBE_MFMA2
                dmy = __builtin_amdgcn_mfma_f32_32x32x16_bf16(fk[c2 & 1][2 * j], qf[2 * c2 + j], dmy, 0, 0, 0);
                dmy = __builtin_amdgcn_mfma_f32_32x32x16_bf16(fk[c2 & 1][2 * j + 1], qf[2 * c2 + j], dmy, 0, 0, 0);
#endif
            }
            __builtin_amdgcn_sched_barrier(0);
        }
    }
#ifdef PROBE_MFMA2
    asm volatile("" :: "v"(dmy));
#endif
}
template <class TS>
__device__ __forceinline__ void v_block(LAS unsigned char* lds, const TS& ts, int tau, int ct, int nt, const bf16_t* Kp, const bf16_t* Vp, long krow0, int kstride, Stage& st,
                                        f32x16 (&O)[4], f32x16& s0, f32x16& s1, bf16x8 (&P)[4], float& m, float& l, int sr, int sc16, int hi) {
    asm volatile("" : "+v"(sr), "+v"(sc16));
#define ATT_ROW(t_, i_) ({ int kp_ = ts.kstart(t_) + sr + 32 * (i_); if (TS::CLAMP) kp_ = kp_ < 0 ? 0 : kp_; ((unsigned)((int)krow0 + kp_ * kstride) * (unsigned)NQKV + (unsigned)(sc16 * 8)) * 2u; })
#define ATT_ISSUE_K(t_) do { if ((t_) >= 0 && (t_) < nt) { _Pragma("unroll") for (int i_ = 0; i_ < 2; ++i_) st.kreg[i_] = *(const u32x4*)((const char*)Kp + ATT_ROW(t_, i_)); } } while (0)
#define ATT_ISSUE_V(t_) do { if ((t_) >= 0 && (t_) < nt) { _Pragma("unroll") for (int i_ = 0; i_ < 2; ++i_) st.vreg[i_] = *(const u32x4*)((const char*)Vp + ATT_ROW(t_, i_)); } } while (0)
#define ATT_COMMIT_K(t_) do { if ((t_) >= 0 && (t_) < nt) { _Pragma("unroll") for (int i_ = 0; i_ < 2; ++i_) *(LAS u32x4*)(lds + ((t_) & 1) * KBYTES + (sr + 32 * i_) * KSTR + sc16 * 16) = st.kreg[i_]; } } while (0)
#define ATT_COMMIT_V(t_) do { if ((t_) >= 0 && (t_) < nt) { _Pragma("unroll") for (int i_ = 0; i_ < 2; ++i_) *(LAS u32x4*)(lds + 2 * KBYTES + ((t_) & 1) * VBYTES + (sr + 32 * i_) * VSTR + sc16 * 16) = st.vreg[i_]; } } while (0)
    ATT_COMMIT_K(ct); ATT_COMMIT_V(ct - 1);
    ATT_ISSUE_K(ct + 1); ATT_ISSUE_V(ct);
#ifdef USE_L2_PREFETCH
    if ((sc16 & 7) == 0) {
        if (ct + 1 + PF_AHEAD < nt) { _Pragma("unroll") for (int i_ = 0; i_ < 2; ++i_) (void)*(const volatile unsigned*)((const char*)Kp + ATT_ROW(ct + 1 + PF_AHEAD, i_)); }
        if (ct + PF_AHEAD < nt && ct + PF_AHEAD >= 0) { _Pragma("unroll") for (int i_ = 0; i_ < 2; ++i_) (void)*(const volatile unsigned*)((const char*)Vp + ATT_ROW(ct + PF_AHEAD, i_)); }
    }
#endif
    const int t = tau + 1;
    if (t >= 0 && t < nt && ts.active(t)) {
        __builtin_amdgcn_s_setprio(1);
        const int ks = ts.kstart(t);
        if (ts.need_mask(t)) {
#pragma unroll
            for (int e = 0; e < 16; ++e) {
                const int kp0 = ks + crow(e, hi), kp1 = kp0 + 32;
                s0[e] = ts.valid(t, ks, kp0) ? s0[e] : NEGR; s1[e] = ts.valid(t, ks, kp1) ? s1[e] : NEGR;
            }
        }
        float mxa = max3f(s0[0], s0[1], s1[0]), mxb = max3f(s0[2], s0[3], s1[1]);
        mxa = max3f(mxa, s1[2], s1[3]);
#pragma unroll
        for (int e = 4; e < 16; e += 4) { mxa = max3f(mxa, s0[e], s0[e + 1]); mxb = max3f(mxb, s0[e + 2], s0[e + 3]); mxa = max3f(mxa, s1[e], s1[e + 1]); mxb = max3f(mxb, s1[e + 2], s1[e + 3]); }
        float mx = max2f(mxa, mxb);
        mx = xhalf_max(mx);
        const float mn = max2f(m, mx * SC);
        if (__any(mn > m)) {
            const float a = __builtin_amdgcn_exp2f(m - mn); l *= a; m = mn;
#pragma unroll
            for (int b = 0; b < 4; ++b)
#pragma unroll
                for (int e = 0; e < 16; ++e) O[b][e] *= a;
        }
        float ps = 0.f, ps1 = 0.f;
#pragma unroll
        for (int e = 0; e < 16; ++e) { s0[e] = __builtin_amdgcn_exp2f(__builtin_fmaf(s0[e], SC, -m)); s1[e] = __builtin_amdgcn_exp2f(__builtin_fmaf(s1[e], SC, -m)); ps += s0[e]; ps1 += s1[e]; }
        l += ps + ps1;
#ifdef PROBE_EXP2
        { float d2 = 0.f;
#pragma unroll
          for (int e = 0; e < 16; ++e) d2 += __builtin_amdgcn_exp2f(s0[e] * 0.5f) + __builtin_amdgcn_exp2f(s1[e] * 0.5f);
          asm volatile("" :: "v"(d2)); }
#endif
        P[0] = pack8(s0, 0); P[1] = pack8(s0, 8); P[2] = pack8(s1, 0); P[3] = pack8(s1, 8);
        __builtin_amdgcn_s_setprio(0);
    }
}
template <class TS>
__device__ __forceinline__ void flash_pass(LAS unsigned char* lds, const bf16_t* Kp, const bf16_t* Vp, long krow0, int kstride,
                                           const bf16x8 (&qf)[8], const TS& ts, f32x16 (&O)[4], float& m, float& l, const int tid) {
#define ATT_BAR() do { asm volatile("s_waitcnt lgkmcnt(0)" ::: "memory"); __builtin_amdgcn_s_barrier(); asm volatile("" ::: "memory"); } while (0)
    const int lane = tid & 63, hi = lane >> 5, grp = __builtin_amdgcn_readfirstlane(tid >> 8);
    const int sr = tid >> 4, sc16 = tid & 15;
    Stage st;
    const int nt = ts.n();
    ATT_ISSUE_K(0); ATT_COMMIT_K(0); ATT_ISSUE_K(1); ATT_ISSUE_V(0);
    ATT_BAR();
    const int kro = (lane & 31) * KSTR + hi * 16;
    const int vro = (4 * hi + ((lane & 15) >> 2)) * VSTR + (((lane >> 4) & 1) * 16 + (lane & 3) * 4) * 2;
    f32x16 s0, s1; bf16x8 P[4];
#pragma unroll
    for (int q = 0; q < 4; ++q) P[q] = (bf16x8){0, 0, 0, 0, 0, 0, 0, 0};
    if (grp == 0) {
        for (int tau = -1; tau < nt; ++tau) {
            m_block(lds, ts, tau, nt, qf, O, s0, s1, P, kro, vro);
            v_block(lds, ts, tau, tau + 2, nt, Kp, Vp, krow0, kstride, st, O, s0, s1, P, m, l, sr, sc16, hi);
            ATT_BAR();
        }
    } else {
        for (int tau = -1; tau < nt; ++tau) {
            v_block(lds, ts, tau - 1, tau + 2, nt, Kp, Vp, krow0, kstride, st, O, s0, s1, P, m, l, sr, sc16, hi);
            m_block(lds, ts, tau, nt, qf, O, s0, s1, P, kro, vro);
            ATT_BAR();
        }
    }
#undef ATT_BAR
#undef ATT_ROW
#undef ATT_ISSUE_K
#undef ATT_ISSUE_V
#undef ATT_COMMIT_K
#undef ATT_COMMIT_V
}

__device__ __forceinline__ void zero_state(f32x16 (&O)[4], float& m, float& l) {
#pragma unroll
    for (int b = 0; b < 4; ++b)
#pragma unroll
        for (int e = 0; e < 16; ++e) O[b][e] = 0.f;
    m = NEG; l = 0.f;
}
__device__ __forceinline__ void store_o(const f32x16 (&O)[4], float scale, bf16_t* dst, int hi) {
#pragma unroll
    for (int b = 0; b < 4; ++b)
#pragma unroll
        for (int g = 0; g < 4; ++g) { u32x2 w; w.x = cvtpk(O[b][4 * g] * scale, O[b][4 * g + 1] * scale); w.y = cvtpk(O[b][4 * g + 2] * scale, O[b][4 * g + 3] * scale);
            *(u32x2*)(dst + 32 * b + 8 * g + 4 * hi) = w; }
}

struct TSDil {
    static constexpr bool CLAMP = true;
    int k0, qlo, qpos;
    __device__ __forceinline__ int n() const { return 6; }
    __device__ __forceinline__ int kstart(int t) const { return k0 + 64 * t; }
    __device__ __forceinline__ bool active(int t) const { const int ks = k0 + 64 * t; return ks <= qlo + 31 && ks + 63 >= qlo - 128; }
    __device__ __forceinline__ bool need_mask(int) const { return true; }
    __device__ __forceinline__ bool valid(int, int, int kpos) const { const int d = qpos - kpos; return d >= 0 && d <= 128 && kpos >= 0; }
};
struct TSCausal {
    static constexpr bool CLAMP = false;
    int nt, qpos, wqhi;
    __device__ __forceinline__ int n() const { return nt; }
    __device__ __forceinline__ int kstart(int t) const { return 64 * t; }
    __device__ __forceinline__ bool active(int t) const { return 64 * t <= wqhi; }
    __device__ __forceinline__ bool need_mask(int t) const { return 64 * t + 63 > wqhi - 31; }
    __device__ __forceinline__ bool valid(int, int, int kpos) const { return kpos <= qpos; }
};
struct TSMoba {
    static constexpr bool CLAMP = false;
    const LAS int* list; int nt, qb, qpos, wqhi; unsigned wmask, lmask, amask;
    __device__ __forceinline__ int n() const { return nt; }
    __device__ __forceinline__ int kstart(int t) const { return list[t]; }
    __device__ __forceinline__ bool active(int t) const { const int ks = list[t], blk = ks >> 8; return blk == qb ? ks <= wqhi : ((wmask >> blk) & 1u) != 0u; }
    __device__ __forceinline__ bool need_mask(int t) const { const int ks = list[t], blk = ks >> 8; return blk == qb ? ks + 63 > wqhi - 31 : ((amask >> blk) & 1u) == 0u; }
    __device__ __forceinline__ bool valid(int, int ks, int kpos) const { const int blk = ks >> 8; return blk == qb ? kpos <= qpos : ((lmask >> blk) & 1u) != 0u; }
};
}

#define XB_TMO      128
#define XB_XCNT(j)  (256  + 64 * (j))
#define XB_XSUB(j)  (1280 + 64 * (j))
#define XB_XGEN(j)  (2304 + 64 * (j))
#define XB_TOP      3328
#define XB_TOPGEN   3392
#define XCD_BAR_WORDS 3456
#define XB_SPIN_CAP (1u << 22)

__device__ __forceinline__ unsigned xb_ld(unsigned* p)              { return __hip_atomic_load(p, __ATOMIC_RELAXED, __HIP_MEMORY_SCOPE_AGENT); }
__device__ __forceinline__ unsigned xb_add(unsigned* p, unsigned v) { return __hip_atomic_fetch_add(p, v, __ATOMIC_RELAXED, __HIP_MEMORY_SCOPE_AGENT); }
__device__ __forceinline__ unsigned xb_xcc_id() { return (unsigned)__builtin_amdgcn_s_getreg((3 << 11) | 20) & 0xFu; }
#define XB_SPIN(cond, bar) do { unsigned _sp = 0; while (cond) { __builtin_amdgcn_s_sleep(1); \
    if ((++_sp & 255u) == 0u) { if (xb_ld(&(bar)[XB_TMO])) break; if (_sp > XB_SPIN_CAP) { atomicAdd(&(bar)[XB_TMO], 1u); break; } } } } while (0)

struct XcdBarrier {
    unsigned* bar; unsigned x;
    volatile LAS unsigned* st;
};

__device__ __forceinline__ XcdBarrier xcd_barrier_post(unsigned* bar, volatile LAS unsigned* st, const bool t0) {
    XcdBarrier b; b.bar = bar; b.x = xb_xcc_id(); b.st = st;
    if (t0) (void)xb_add(&bar[XB_XCNT(b.x)], 1u);
    return b;
}
__device__ __forceinline__ void xcd_barrier_complete(unsigned* bar, unsigned x, unsigned& nloc, unsigned& nx) {
    const unsigned G = gridDim.x * gridDim.y * gridDim.z;
    unsigned sum, cnt, mine, sp = 0u;
    for (;;) {
        sum = 0u; cnt = 0u; mine = 0u;
#pragma unroll
        for (unsigned j = 0; j < 16; ++j) { const unsigned c = xb_ld(&bar[XB_XCNT(j)]); sum += c; cnt += (c > 0u) ? 1u : 0u; mine = (j == x) ? c : mine; }
        if (sum == G) break;
        __builtin_amdgcn_s_sleep(1);
        if ((++sp & 255u) == 0u) { if (xb_ld(&bar[XB_TMO])) break; if (sp > XB_SPIN_CAP) { atomicAdd(&bar[XB_TMO], 1u); break; } }
    }
    nloc = mine > 0u ? mine : 1u; nx = cnt > 0u ? cnt : 1u;
}

__device__ __forceinline__ void xcd_barrier(const XcdBarrier& b, const bool t0) {
    asm volatile("s_waitcnt vmcnt(0)" ::: "memory");
    __syncthreads();
    if (t0) {
        unsigned* bar = b.bar;
        __builtin_amdgcn_s_waitcnt(0);
        unsigned nloc = b.st[0], nx = b.st[1];
        if (nloc == 0u) { xcd_barrier_complete(bar, b.x, nloc, nx); b.st[0] = nloc; b.st[1] = nx; }
        const unsigned old = xb_add(&bar[XB_XSUB(b.x)], 1u);
        const unsigned gen = old / nloc;
        if (old + 1u == (gen + 1u) * nloc) {
            __builtin_amdgcn_fence(__ATOMIC_RELEASE, "agent");
            asm volatile("s_waitcnt vmcnt(0)" ::: "memory");
            const unsigned og = xb_add(&bar[XB_TOP], 1u);
            const unsigned tg = og / nx;
            if (og + 1u == (tg + 1u) * nx) xb_add(&bar[XB_TOPGEN], 1u);
            else XB_SPIN(xb_ld(&bar[XB_TOPGEN]) == tg, bar);
            __builtin_amdgcn_fence(__ATOMIC_ACQUIRE, "agent");
            xb_add(&bar[XB_XGEN(b.x)], 1u);
            asm volatile("s_waitcnt vmcnt(0)" ::: "memory");
        } else {
            XB_SPIN(xb_ld(&bar[XB_XGEN(b.x)]) == gen, bar);
            __builtin_amdgcn_fence(__ATOMIC_ACQUIRE, "agent");
            asm volatile("s_waitcnt vmcnt(0)" ::: "memory");
        }
    }
    __syncthreads();
}

#define AS4 __attribute__((address_space(4)))
#define PHASE_WS() const AS4 unsigned char* ka_ = (const AS4 unsigned char*)__builtin_amdgcn_kernarg_segment_ptr(); asm volatile("" : "+s"(ka_)); unsigned char* ws = *(unsigned char* const AS4*)(ka_ + 152)
#define PIN(i) (*(const float* const AS4*)(ka_ + 8 * (i)))
#define XIN PIN(0)
#define HBUF (*(float* const AS4*)(ka_ + 144))
__global__ void __launch_bounds__(512) fwd_megakernel(Params P) {
    extern __shared__ __attribute__((aligned(16))) unsigned char lds_raw[];
    LAS unsigned char* lds = (LAS unsigned char*)lds_raw;
    cg::grid_group grid = cg::this_grid();
    grid.sync();
    const int G = gridDim.x, bx = blockIdx.x, NGW = G * 8;
    const int wave_s = __builtin_amdgcn_readfirstlane((int)threadIdx.x >> 6);
#define PHASE_IDS() PHASE_WS(); int tid; asm volatile("v_mbcnt_lo_u32_b32 %0, -1, 0\n\tv_mbcnt_hi_u32_b32 %0, -1, %0" : "=v"(tid)); tid += wave_s * 64; const int lane = tid & 63, wave = wave_s, hi = lane >> 5, gw = bx * 8 + wave; (void)hi; (void)gw; (void)lane
    volatile LAS unsigned* xst = (volatile LAS unsigned*)(lds + 131072);
    { int l_; asm volatile("v_mbcnt_lo_u32_b32 %0, -1, 0\n\tv_mbcnt_hi_u32_b32 %0, -1, %0" : "=v"(l_)); if ((l_ + wave_s * 64) < 2) xst[l_] = 0u; }
    __syncthreads();
    XcdBarrier xbar;
    { int l_; asm volatile("v_mbcnt_lo_u32_b32 %0, -1, 0\n\tv_mbcnt_hi_u32_b32 %0, -1, %0" : "=v"(l_)); PHASE_WS(); xbar = xcd_barrier_post((unsigned*)(ws + WS_CTL), xst, (l_ + wave_s * 64) == 0); }
#define XN ((bf16_t*)(ws + WS_XN))
#define BIG ((bf16_t*)(ws + WS_BIG))
#define ATT ((bf16_t*)(ws + WS_ATT))
#define PART ((bf16_t*)(ws + WS_PART))
#define LSE ((float*)(ws + WS_LSE))
#define COS ((float*)(ws + WS_ROPE))
#define SIN (COS + SEQ * 64)
#define KMEAN ((float*)(ws + WS_KMEAN))
    constexpr unsigned long long ROPE_EVEN = 0x000000FFFF00FFFFull;
    constexpr unsigned long long ROPE_ODD = 0x00000000FFFFFFFFull;

    {
        PHASE_IDS();
        LAS float* scr = (LAS float*)(lds + wave * 8448);
#ifndef NO_TRANSP
        for (int rep = 0; rep < REP_PRO; ++rep) {
        for (int l = 0; l < 2; ++l) {
            transpose_items<1>(PIN(2) + (size_t)l * DM * 2 * DFF, DM, 2 * DFF, (bf16_t*)(ws + WS_FFA_IN + l * SZ_WIN), 0, scr, gw, NGW, lane);
            transpose_items<0>(PIN(3) + (size_t)l * DFF * DM, DFF, DM, (bf16_t*)(ws + WS_FFA_OUT + l * SZ_WOUT), 0, scr, gw, NGW, lane);
            transpose_items<1>(PIN(15) + (size_t)l * DM * 2 * DFF, DM, 2 * DFF, (bf16_t*)(ws + WS_FFB_IN + l * SZ_WIN), 0, scr, gw, NGW, lane);
            transpose_items<0>(PIN(16) + (size_t)l * DFF * DM, DFF, DM, (bf16_t*)(ws + WS_FFB_OUT + l * SZ_WOUT), 0, scr, gw, NGW, lane);
        }
        transpose_items<2>(PIN(5), DM, NQKV, (bf16_t*)(ws + WS_MIX_IN), ROPE_EVEN, scr, gw, NGW, lane);
        transpose_items<2>(PIN(7), DM, NQKV, (bf16_t*)(ws + WS_MIX_IN + SZ_WMIN), ROPE_ODD, scr, gw, NGW, lane);
        transpose_items<0>(PIN(6), DM, DM, (bf16_t*)(ws + WS_MIX_OUT), 0, scr, gw, NGW, lane);
        transpose_items<0>(PIN(8), DM, DM, (bf16_t*)(ws + WS_MIX_OUT + SZ_WMOUT), 0, scr, gw, NGW, lane);
        }
#endif
#ifndef NO_ROPETAB
        for (int idx = bx * 512 + tid; idx < SEQ * 64; idx += G * 512) {
            const int pos = idx >> 6, j = idx & 63;
            const float inv = (float)pow(10000.0, -(double)j / 64.0);
            const float ang = (float)pos * inv;
            const double a = (double)ang, n = rint(a * 0.15915494309189535);
            const double r = (a - n * 6.283185307179586) - n * 2.4492935982947064e-16;
            COS[idx] = (float)cos(r); SIN[idx] = (float)sin(r);
        }
#endif
        norm_phase<false>(XIN, PIN(1), XN, gw, NGW, lane);
    }
    GSYNC();

    for (int layer = 0; layer < 2; ++layer) {
        {
            PHASE_WS();
            pg8::Gemm g{XN, (const bf16_t*)(ws + WS_FFA_IN + layer * SZ_WIN), MTOK, 2 * DFF, DM}; pg8::StaticOrder S; { int g_ = G, b_ = bx; asm volatile("" : "+s"(g_), "+s"(b_)); S.init(MTOK, 2 * DFF, g_, b_); }
            pg8::EpiSwiGLU E{BIG, DFF};
#ifndef NO_EPISWIGLU
            for (int rep = 0; rep < REP_SWI; ++rep) pg8::gemm_phase<pg8::EpiSwiGLU, pg8::StaticOrder, true, true>(lds, g, S, E, wave_s);
#endif
        }
        GSYNC();
        {
            PHASE_WS();
            pg8::Gemm g{BIG, (const bf16_t*)(ws + WS_FFA_OUT + layer * SZ_WOUT), MTOK, DM, DFF}; pg8::StaticOrder S; { int g_ = G, b_ = bx; asm volatile("" : "+s"(g_), "+s"(b_)); S.init(MTOK, DM, g_, b_); }
            pg8::EpiResid E{layer == 0 ? XIN : HBUF, HBUF, DM, 0.5f};
#ifndef NO_EPIRESID
            for (int rep = 1; rep < REP_RES; ++rep) { pg8::EpiResid E0 = E; E0.scale = 0.f; pg8::gemm_phase<pg8::EpiResid, pg8::StaticOrder, true, true>(lds, g, S, E0, wave_s); }
            pg8::gemm_phase<pg8::EpiResid, pg8::StaticOrder, true, true>(lds, g, S, E, wave_s);
#endif
        }
        GSYNC();
        { PHASE_IDS(); for (int rep = 0; rep < REP_NORM; ++rep) norm_phase<false>(HBUF, PIN(4) + layer * DM, XN, gw, NGW, lane); }
        GSYNC();
        {
            PHASE_WS();
            pg8::Gemm g{XN, (const bf16_t*)(ws + WS_MIX_IN + layer * SZ_WMIN), MTOK, NQKV, DM}; pg8::StaticOrder S; { int g_ = G, b_ = bx; asm volatile("" : "+s"(g_), "+s"(b_)); S.init(MTOK, NQKV, g_, b_); }
            pg8::EpiQKV E{BIG, NQKV, COS, SIN, layer == 0 ? ROPE_EVEN : ROPE_ODD};
#ifndef NO_EPIQKV
            for (int rep = 0; rep < REP_QKV; ++rep) pg8::gemm_phase<pg8::EpiQKV, pg8::StaticOrder, true, true>(lds, g, S, E, wave_s);
#endif
        }
        GSYNC();
        if (layer == 0) {
            PHASE_IDS();
            for (int rep = 0; rep < REP_DIL; ++rep) {
            for (int it = bx; it < 512; it += G) {
                const int b = it >> 8, h = (it >> 5) & 7, blk = it & 31, c = tid & 127, rg = tid >> 7;
                const bf16_t* kp = BIG + (size_t)(b * SEQ + blk * 256 + rg * 64) * NQKV + 4096 + h * 128 + c;
                float s = 0.f;
                for (int r = 0; r < 64; ++r) s += bf2f(kp[(size_t)r * NQKV]);
                LAS float* red = (LAS float*)lds;
                red[rg * 128 + c] = s; __syncthreads();
                if (tid < 128) KMEAN[(size_t)it * 128 + tid] = (red[tid] + red[128 + tid] + red[256 + tid] + red[384 + tid]) * (1.0f / 256.0f);
                __syncthreads();
            }
#ifndef NO_DIL
            for (int un = bx; un < 1536; un += G) {
                const int u = un & 31, br = (un >> 5) % 3, bh = un / 96, b = bh >> 3, h = bh & 7;
                const int dl = br == 0 ? 1 : (br == 1 ? 4 : 16);
                const int upr = 32 / dl, res = u / upr, ub = u % upr;
                const long row0 = (long)b * SEQ + res;
                const int qlo = 256 * ub + 32 * wave, qpos = qlo + (lane & 31);
                bf16x8 qf[8]; att::load_q(qf, BIG + h * 128, row0 + (long)qpos * dl, hi);
                f32x16 O[4]; float m, l; att::zero_state(O, m, l);
                att::TSDil ts{256 * ub - 128, qlo, qpos};
                att::flash_pass(lds, BIG + 1024 + h * 128, BIG + 2048 + h * 128, row0, dl, qf, ts, O, m, l, tid);
                l = att::xhalf_sum(l);
                const long grow = row0 + (long)qpos * dl;
                att::store_o(O, 1.0f / l, PART + ((size_t)br * MTOK + grow) * 1024 + h * 128, hi);
                if (hi == 0) LSE[((size_t)br * MTOK + grow) * 8 + h] = m + log2f(l);
            }
#endif
            }
        } else {
            PHASE_IDS();
#ifndef NO_DIFF
            const float lam_init = 0.35550906759096927f;
            float d1 = 0.f, d2 = 0.f;
            for (int i = 0; i < 128; ++i) { d1 += PIN(9)[i] * PIN(10)[i]; d2 += PIN(11)[i] * PIN(12)[i]; }
            const float lam = __uint_as_float(__builtin_amdgcn_readfirstlane(__float_as_uint(expf(d1) - expf(d2) + lam_init)));
            float* park = (float*)PART + (size_t)bx * 3 * 64 * 512;
            for (int rep = 0; rep < REP_DIFF; ++rep)
            for (int un = bx; un < 512; un += G) {
                const int sel = un & 255, bh = sel >> 4, qb = (un < 256) ? 31 - (sel & 15) : (sel & 15), b = bh >> 3, h = bh & 7;
                const long row0 = (long)b * SEQ;
                const int qlo = 256 * qb + 32 * wave, qpos = qlo + (lane & 31);
                f32x16 O[4]; float m, l; float ss = 0.f;
#pragma unroll 1
                for (int pass = 0; pass < 4; ++pass) {
                    const int pr = pass & 1, hf = pass >> 1;
                    bf16x8 qf[8]; att::load_q(qf, BIG + h * 256 + pr * 128, row0 + qpos, hi);
                    att::zero_state(O, m, l);
                    att::TSCausal ts{4 * (qb + 1), qpos, qlo + 31};
                    att::flash_pass(lds, BIG + 2048 + h * 256 + pr * 128, BIG + 4096 + h * 256 + hf * 128, row0, 1, qf, ts, O, m, l, tid);
                    l = att::xhalf_sum(l);
                    const float il = 1.0f / l;
                    f32x4* pk = (f32x4*)(park + (size_t)hf * 64 * 512 + (size_t)tid * 64);
                    if (pr == 0) {
#pragma unroll
                        for (int bb = 0; bb < 4; ++bb)
#pragma unroll
                            for (int g4 = 0; g4 < 4; ++g4) pk[bb * 4 + g4] = (f32x4){O[bb][4 * g4], O[bb][4 * g4 + 1], O[bb][4 * g4 + 2], O[bb][4 * g4 + 3]} * il;
                    } else {
#pragma unroll
                        for (int bb = 0; bb < 4; ++bb)
#pragma unroll
                            for (int g4 = 0; g4 < 4; ++g4) { const f32x4 pv = pk[bb * 4 + g4];
#pragma unroll
                                for (int i = 0; i < 4; ++i) { const float v = pv[i] - lam * (O[bb][4 * g4 + i] * il); O[bb][4 * g4 + i] = v; ss += v * v; } }
                        if (hf == 0) {
#pragma unroll
                            for (int bb = 0; bb < 4; ++bb)
#pragma unroll
                                for (int g4 = 0; g4 < 4; ++g4) pk[bb * 4 + g4] = (f32x4){O[bb][4 * g4], O[bb][4 * g4 + 1], O[bb][4 * g4 + 2], O[bb][4 * g4 + 3]};
                        }
                    }
                }
                ss = att::xhalf_sum(ss);
                const float rs = (1.0f - lam_init) / sqrtf(ss * (1.0f / 256.0f) + 1e-5f);
                const float* sg = PIN(13);
                bf16_t* dst = ATT + (size_t)(row0 + qpos) * DM + h * 256;
#pragma unroll
                for (int half = 1; half >= 0; --half) {
                    if (half == 0) {
#pragma unroll
                        for (int bb = 0; bb < 4; ++bb)
#pragma unroll
                            for (int g4 = 0; g4 < 4; ++g4) { const f32x4 pv = ((const f32x4*)(park + (size_t)tid * 64))[bb * 4 + g4];
#pragma unroll
                                for (int i = 0; i < 4; ++i) O[bb][4 * g4 + i] = pv[i]; }
                    }
#pragma unroll
                    for (int bb = 0; bb < 4; ++bb)
#pragma unroll
                        for (int g4 = 0; g4 < 4; ++g4) {
                            const f32x4 ga = *(const f32x4*)(sg + half * 128 + 32 * bb + 8 * g4 + 4 * hi);
#pragma unroll
                            for (int i = 0; i < 4; ++i) O[bb][4 * g4 + i] *= ga[i];
                        }
                    att::store_o(O, rs, dst + half * 128, hi);
                }
                __syncthreads();
            }
#endif
        }
        GSYNC();
        if (layer == 0) {
            PHASE_IDS();
            for (int rep = 0; rep < REP_MOBA; ++rep) {
            for (int idx = bx * 512 + tid; idx < MTOK * 128; idx += G * 512) {
                const int row = idx >> 7, h = (idx >> 4) & 7, ch = idx & 15;
                float L[3]; u32x4 pv[3];
#pragma unroll
                for (int br = 0; br < 3; ++br) { L[br] = LSE[((size_t)br * MTOK + row) * 8 + h]; pv[br] = *(const u32x4*)(PART + ((size_t)br * MTOK + row) * 1024 + h * 128 + ch * 8); }
                const float mx = fmaxf(L[0], fmaxf(L[1], L[2]));
                float w[3]; float sw = 0.f;
#pragma unroll
                for (int br = 0; br < 3; ++br) { w[br] = __builtin_amdgcn_exp2f(L[br] - mx); sw += w[br]; }
                const float isw = 1.0f / sw;
                float o[8];
#pragma unroll
                for (int i = 0; i < 8; ++i) o[i] = 0.f;
#pragma unroll
                for (int br = 0; br < 3; ++br) { const float wb = w[br] * isw;
#pragma unroll
                    for (int i = 0; i < 4; ++i) { const unsigned wd = pv[br][i]; o[2 * i] += wb * bf2f((unsigned short)(wd & 0xffffu)); o[2 * i + 1] += wb * bf2f((unsigned short)(wd >> 16)); } }
                u32x4 r; r.x = pk2(o[0], o[1]); r.y = pk2(o[2], o[3]); r.z = pk2(o[4], o[5]); r.w = pk2(o[6], o[7]);
                *(u32x4*)(ATT + (size_t)row * DM + h * 128 + ch * 8) = r;
            }
#ifndef NO_MOBA
            LAS float* kmL = (LAS float*)(lds + 77824);
            LAS unsigned* selL = (LAS unsigned*)(lds + 94208);
            LAS unsigned* wmL = (LAS unsigned*)(lds + 95232);
            LAS int* listL = (LAS int*)(lds + 95296);
            for (int un = bx; un < 512; un += G) {
                const int sel = un & 255, bh = sel >> 4, qb = (un < 256) ? 31 - (sel & 15) : (sel & 15), b = bh >> 3, h = bh & 7;
                const long row0 = (long)b * SEQ;
                for (int i = tid; i < qb * 128; i += 512) kmL[i] = KMEAN[(size_t)(bh * 32) * 128 + i];
                __syncthreads();
                {
                    const int q = tid >> 1, part = tid & 1;
                    const bf16_t* qp = BIG + (size_t)(row0 + qb * 256 + q) * NQKV + 3072 + h * 128 + 64 * part;
                    float qv[64];
#pragma unroll
                    for (int c = 0; c < 8; ++c) { const u32x4 w = *(const u32x4*)(qp + 8 * c);
#pragma unroll
                        for (int i = 0; i < 4; ++i) { qv[8 * c + 2 * i] = bf2f((unsigned short)(w[i] & 0xffffu)); qv[8 * c + 2 * i + 1] = bf2f((unsigned short)(w[i] >> 16)); } }
                    float v0 = -3e38f, v1 = -3e38f, v2 = -3e38f; int i0 = -1, i1 = -1, i2 = -1;
                    for (int j = 0; j < qb; ++j) {
                        const LAS float* km = kmL + j * 128 + 64 * part; float d = 0.f;
#pragma unroll
                        for (int i = 0; i < 64; ++i) d += qv[i] * km[i];
                        d += shfl_xor_f(d, 1, lane);
                        if (d > v0) { v2 = v1; i2 = i1; v1 = v0; i1 = i0; v0 = d; i0 = j; }
                        else if (d > v1) { v2 = v1; i2 = i1; v1 = d; i1 = j; }
                        else if (d > v2) { v2 = d; i2 = j; }
                    }
                    unsigned mk = 0u; if (i0 >= 0) mk |= 1u << i0; if (i1 >= 0) mk |= 1u << i1; if (i2 >= 0) mk |= 1u << i2;
                    if (part == 0) selL[q] = mk;
                }
                __syncthreads();
                const unsigned lmask = selL[32 * wave + (lane & 31)];
                unsigned wm = lmask, am = lmask;
#pragma unroll
                for (int o = 1; o < 64; o <<= 1) { wm |= (unsigned)shfl_xor_i((int)wm, o, lane); am &= (unsigned)shfl_xor_i((int)am, o, lane); }
                if (lane == 0) wmL[wave] = wm;
                __syncthreads();
                if (tid == 0) {
                    unsigned U = 0u; for (int w = 0; w < 8; ++w) U |= wmL[w];
                    int n = 0;
                    for (int j = 0; j < qb; ++j) if ((U >> j) & 1u) { for (int i = 0; i < 4; ++i) listL[n++] = 256 * j + 64 * i; }
                    for (int i = 0; i < 4; ++i) listL[n++] = 256 * qb + 64 * i;
                    listL[130] = n;
                }
                __syncthreads();
                const int qlo = 256 * qb + 32 * wave, qpos = qlo + (lane & 31);
                bf16x8 qf[8]; att::load_q(qf, BIG + 3072 + h * 128, row0 + qpos, hi);
                f32x16 O[4]; float m, l; att::zero_state(O, m, l);
                att::TSMoba ts{listL, listL[130], qb, qpos, qlo + 31, wm, lmask, am};
                att::flash_pass(lds, BIG + 4096 + h * 128, BIG + 5120 + h * 128, row0, 1, qf, ts, O, m, l, tid);
                l = att::xhalf_sum(l);
                att::store_o(O, 1.0f / l, ATT + (size_t)(row0 + qpos) * DM + 1024 + h * 128, hi);
                __syncthreads();
            }
#endif
            }
            GSYNC();
        }
        {
            PHASE_WS();
            pg8::Gemm g{ATT, (const bf16_t*)(ws + WS_MIX_OUT + layer * SZ_WMOUT), MTOK, DM, DM}; pg8::StaticOrder S; { int g_ = G, b_ = bx; asm volatile("" : "+s"(g_), "+s"(b_)); S.init(MTOK, DM, g_, b_); }
            pg8::EpiResid E{HBUF, HBUF, DM, 1.0f};
#ifndef NO_EPIRESID
            for (int rep = 1; rep < REP_RES; ++rep) { pg8::EpiResid E0 = E; E0.scale = 0.f; pg8::gemm_phase<pg8::EpiResid, pg8::StaticOrder, true, true>(lds, g, S, E0, wave_s); }
            pg8::gemm_phase<pg8::EpiResid, pg8::StaticOrder, true, true>(lds, g, S, E, wave_s);
#endif
        }
        GSYNC();
        { PHASE_IDS(); for (int rep = 0; rep < REP_NORM; ++rep) norm_phase<false>(HBUF, PIN(14) + layer * DM, XN, gw, NGW, lane); }
        GSYNC();
        {
            PHASE_WS();
            pg8::Gemm g{XN, (const bf16_t*)(ws + WS_FFB_IN + layer * SZ_WIN), MTOK, 2 * DFF, DM}; pg8::StaticOrder S; { int g_ = G, b_ = bx; asm volatile("" : "+s"(g_), "+s"(b_)); S.init(MTOK, 2 * DFF, g_, b_); }
            pg8::EpiSwiGLU E{BIG, DFF};
#ifndef NO_EPISWIGLU
            for (int rep = 0; rep < REP_SWI; ++rep) pg8::gemm_phase<pg8::EpiSwiGLU, pg8::StaticOrder, true, true>(lds, g, S, E, wave_s);
#endif
        }
        GSYNC();
        {
            PHASE_WS();
            pg8::Gemm g{BIG, (const bf16_t*)(ws + WS_FFB_OUT + layer * SZ_WOUT), MTOK, DM, DFF}; pg8::StaticOrder S; { int g_ = G, b_ = bx; asm volatile("" : "+s"(g_), "+s"(b_)); S.init(MTOK, DM, g_, b_); }
            pg8::EpiResid E{HBUF, HBUF, DM, 0.5f};
#ifndef NO_EPIRESID
            for (int rep = 1; rep < REP_RES; ++rep) { pg8::EpiResid E0 = E; E0.scale = 0.f; pg8::gemm_phase<pg8::EpiResid, pg8::StaticOrder, true, true>(lds, g, S, E0, wave_s); }
            pg8::gemm_phase<pg8::EpiResid, pg8::StaticOrder, true, true>(lds, g, S, E, wave_s);
#endif
        }
        GSYNC();
        if (layer == 0) { { PHASE_IDS(); norm_phase<false>(HBUF, PIN(1) + DM, XN, gw, NGW, lane); } GSYNC(); }
        else { PHASE_IDS(); norm_phase<true>(HBUF, PIN(17), HBUF, gw, NGW, lane); }
    }
}

extern "C" void kernel_launch(void* const* d_in, const int* in_sizes, int n_in, void* d_out, int out_size, void* d_ws, size_t ws_size, hipStream_t stream) {
    static int grid_blocks = 0;
    if (grid_blocks == 0) {
        if (n_in != 18 || ws_size < WS_END) { fprintf(stderr, "kernel_launch: need 18 inputs and %zu bytes of workspace; got %d, %zu\n", (size_t)WS_END, n_in, ws_size); grid_blocks = -1; return; }
        int dev = 0, cus = 0, per_cu = 0;
        hipGetDevice(&dev);
        hipDeviceGetAttribute(&cus, hipDeviceAttributeMultiprocessorCount, dev);
        hipFuncSetAttribute((const void*)fwd_megakernel, hipFuncAttributeMaxDynamicSharedMemorySize, LDS_BYTES);
        hipOccupancyMaxActiveBlocksPerMultiprocessor(&per_cu, (const void*)fwd_megakernel, 512, LDS_BYTES);
        if (per_cu < 1) { fprintf(stderr, "kernel_launch: occupancy query says %d blocks per CU\n", per_cu); per_cu = 1; }
        (void)hipGetLastError();
        grid_blocks = cus * per_cu;
    }
    if (grid_blocks < 0) return;
    if (hipMemsetAsync((char*)d_ws + WS_CTL, 0, CTL_BYTES, stream) != hipSuccess) { fprintf(stderr, "kernel_launch: hipMemsetAsync failed\n"); return; }
    Params p{};
    for (int i = 0; i < 18; ++i) p.in[i] = (const float*)d_in[i];
    p.out = (float*)d_out; p.ws = (unsigned char*)d_ws;
    void* args[] = {&p};
    hipError_t e = hipLaunchCooperativeKernel((const void*)fwd_megakernel, dim3(grid_blocks), dim3(512), args, LDS_BYTES, stream);
    if (e != hipSuccess) fprintf(stderr, "cooperative launch failed: %s (grid %d)\n", hipGetErrorString(e), grid_blocks);
}
```

```cpp
#include <hip/hip_runtime.h>
#include <hip/hip_cooperative_groups.h>
#include <cstdio>
#include <cstdint>
namespace cg = cooperative_groups;
namespace pg8 {
#define PG8_LAS __attribute__((address_space(3)))
typedef unsigned short bf16_t;
typedef short bf16x8 __attribute__((ext_vector_type(8)));
typedef float f32x4 __attribute__((ext_vector_type(4)));
typedef unsigned u32x4 __attribute__((ext_vector_type(4)));
constexpr int BM = 256, BK = 64, HALF = 128, HTB = HALF * BK * 2  , STAGE_BYTES = 8 * HTB, NXCD = 8, WGM = 8;

__host__ __device__ __forceinline__ int lds_byte(int r, int c) { const int st = (r >> 4) * 2 + (c >> 5), rr = r & 15, cc = c & 31, ob = rr * 64 + cc * 2; return st * 1024 + (ob ^ (((ob >> 9) & 1) << 5)); }
__host__ __device__ __forceinline__ void stage_rc(int b, int& R, int& C) { const int st = b / 1024, sb = b % 1024, swz = sb ^ (((sb >> 9) & 1) << 5); R = (st >> 1) * 16 + swz / 64; C = (st & 1) * 32 + (swz % 64) / 2; }
__host__ __device__ __forceinline__ int perm32(int rho) { const int n = rho >> 4, i = rho & 15; return 8 * (i >> 2) + 4 * n + (i & 3); }

struct Unit { int pm, pn; };
struct Gemm { const bf16_t* A; const bf16_t* Bt; int M, N, K; };

struct StaticOrder {
    int nM, nN, nwg, G, c;
    __host__ __device__ void init(int M, int N, int G_, int c_) { nM = M / BM; nN = N / BM; nwg = nM * nN; G = G_; c = c_; }
    __host__ __device__ bool next(int i, Unit& u) const {
        const long L = (long)i * G + c; if (L >= nwg) return false;
        int wgid = (int)L; { const int q = nwg / NXCD, r = nwg % NXCD, xcd = wgid % NXCD, off = wgid / NXCD; wgid = (xcd < r ? xcd * (q + 1) : r * (q + 1) + (xcd - r) * q) + off; }
        const int nig = WGM * nN, gid = wgid / nig, fm = gid * WGM, gsz = (nM - fm) < WGM ? (nM - fm) : WGM;
        u.pm = fm + ((wgid % nig) % gsz); u.pn = (wgid % nig) / gsz; return true;
    }
    __device__ __forceinline__ void a_ready(const Unit&) const {}
    __device__ __forceinline__ void done(const Unit&) const {}
};

__device__ __forceinline__ unsigned cvt_pk_bf16(float lo, float hi) { unsigned r; asm volatile("v_cvt_pk_bf16_f32 %0, %1, %2" : "=v"(r) : "v"(lo), "v"(hi)); return r; }
typedef float f32x2 __attribute__((ext_vector_type(2)));
struct EpiSwiGLU {
    static constexpr bool PERM = true, AFTER_DRAIN = false;
    bf16_t* O; int ldc;
    __device__ __forceinline__ void operator()(const f32x4 (&acc)[2][2][4][2], const Unit& u, int wr, int wc, int fr, int fq) const {
        const int row0 = u.pm * BM + wr * 64 + fr, col0 = u.pn * HALF + wc * 32 + 8 * fq;
#pragma unroll
        for (int ai = 0; ai < 2; ++ai)
#pragma unroll
            for (int m = 0; m < 4; ++m) {
                bf16_t* rowp = O + (size_t)(row0 + ai * HALF + m * 16) * ldc + col0;
                float h[8];
#pragma unroll
                for (int n = 0; n < 2; ++n)
#pragma unroll
                    for (int e = 0; e < 4; ++e) { const float g = acc[ai][0][m][n][e], up = acc[ai][1][m][n][e];
                        const float sg = __builtin_amdgcn_rcpf(1.0f + __builtin_amdgcn_exp2f(-1.4426950408889634f * g)); h[n * 4 + e] = g * sg * up; }
                u32x4 w; w.x = cvt_pk_bf16(h[0], h[1]); w.y = cvt_pk_bf16(h[2], h[3]); w.z = cvt_pk_bf16(h[4], h[5]); w.w = cvt_pk_bf16(h[6], h[7]);
                *(u32x4*)rowp = w;
            }
    }
};
struct EpiResid {
    static constexpr bool PERM = true, AFTER_DRAIN = false;
    const float* base; float* out; int ldc; float scale;
    __device__ __forceinline__ void operator()(const f32x4 (&acc)[2][2][4][2], const Unit& u, int wr, int wc, int fr, int fq) const {
        const int row0 = u.pm * BM + wr * 64 + fr, col0 = u.pn * BM + wc * 32 + 8 * fq;
#pragma unroll
        for (int ai = 0; ai < 2; ++ai)
#pragma unroll
            for (int m = 0; m < 4; ++m)
#pragma unroll
                for (int bj = 0; bj < 2; ++bj) {
                    const size_t p = (size_t)(row0 + ai * HALF + m * 16) * ldc + col0 + bj * HALF;
                    const f32x4 b0 = *(const f32x4*)(base + p), b1 = *(const f32x4*)(base + p + 4);
                    *(f32x4*)(out + p) = b0 + acc[ai][bj][m][0] * scale; *(f32x4*)(out + p + 4) = b1 + acc[ai][bj][m][1] * scale;
                }
    }
};
struct EpiQKV {
    static constexpr bool PERM = true, AFTER_DRAIN = false;
    bf16_t* O; int ldc; const float* cosT; const float* sinT; unsigned long long ropemask;
    __device__ __forceinline__ void operator()(const f32x4 (&acc)[2][2][4][2], const Unit& u, int wr, int wc, int fr, int fq) const {
        const int row0 = u.pm * BM + wr * 64 + fr, col0 = u.pn * BM + wc * 32 + 8 * fq, j0 = 16 * wc + 4 * fq;
#pragma unroll
        for (int ai = 0; ai < 2; ++ai)
#pragma unroll
            for (int m = 0; m < 4; ++m) {
                const int row = row0 + ai * HALF + m * 16, pos = row & 8191;
                const f32x4 cs = *(const f32x4*)(cosT + pos * 64 + j0), sn = *(const f32x4*)(sinT + pos * 64 + j0);
#pragma unroll
                for (int bj = 0; bj < 2; ++bj) {
                    const bool roped = (ropemask >> (u.pn * 2 + bj)) & 1ull;
                    f32x4 v0 = acc[ai][bj][m][0], v1 = acc[ai][bj][m][1];
                    if (roped) {
                        const f32x4 a = v0, b = v1;
                        v0[0] = a[0] * cs[0] - a[1] * sn[0]; v0[1] = a[1] * cs[0] + a[0] * sn[0];
                        v0[2] = a[2] * cs[1] - a[3] * sn[1]; v0[3] = a[3] * cs[1] + a[2] * sn[1];
                        v1[0] = b[0] * cs[2] - b[1] * sn[2]; v1[1] = b[1] * cs[2] + b[0] * sn[2];
                        v1[2] = b[2] * cs[3] - b[3] * sn[3]; v1[3] = b[3] * cs[3] + b[2] * sn[3];
                    }
                    u32x4 w; w.x = cvt_pk_bf16(v0[0], v0[1]); w.y = cvt_pk_bf16(v0[2], v0[3]); w.z = cvt_pk_bf16(v1[0], v1[1]); w.w = cvt_pk_bf16(v1[2], v1[3]);
                    *(u32x4*)(O + (size_t)row * ldc + col0 + bj * HALF) = w;
                }
            }
    }
};
template <class Epi, class Sched, bool ALIGN_EPI = false, bool SP2 = false>
__device__ __forceinline__ void gemm_phase(PG8_LAS unsigned char* lds, const Gemm g, const Sched& S, const Epi& E, const int wave_s  ) {
    int tid_; asm volatile("v_mbcnt_lo_u32_b32 %0, -1, 0\n\tv_mbcnt_hi_u32_b32 %0, -1, %0" : "=v"(tid_)); tid_ += wave_s * 64;
    const int tid = tid_, wid = __builtin_amdgcn_readfirstlane(tid >> 6), lane = tid & 63, wr = wid >> 2, wc = wid & 3, fr = lane & 15, fq = lane >> 4;
    const int K = g.K, nt = K / BK;
    unsigned voffA[2], voffB[2];
#pragma unroll
    for (int i = 0; i < 2; ++i) { int R, C; stage_rc(tid * 16 + i * 8192, R, C); const int Rb = Epi::PERM ? ((R & ~31) + perm32(R & 31)) : R;
        voffA[i] = (unsigned)(R * K + C) * 2u; voffB[i] = (unsigned)(Rb * K + C) * 2u; }
    const size_t kstep = (size_t)(BK * 2);
    const size_t hstep = (size_t)HALF * K * 2;
    const size_t tstep = 2 * hstep;
    const unsigned ldsw = (unsigned)wid * 1024u;
    const int aoff = lds_byte(wr * 64 + fr, fq * 8), boff = lds_byte(wc * 32 + fr, fq * 8);
#define PG8_SA(b, h) (((b) * 2 + (h)) * HTB)
#define PG8_SB(b, h) ((4 + (b) * 2 + (h)) * HTB)
#define PG8_STAGE(bufoff, gbase, voff) do { _Pragma("unroll") for (int _i = 0; _i < 2; ++_i) \
        __builtin_amdgcn_global_load_lds((const unsigned*)((const char*)(gbase) + (voff)[_i]), (PG8_LAS unsigned*)(lds + (bufoff) + ldsw + _i * 8192), 16, 0, 0); } while (0)
#define PG8_LDA(dst, b, h) do { _Pragma("unroll") for (int m = 0; m < 4; ++m) _Pragma("unroll") for (int k = 0; k < 2; ++k) dst[m][k] = *(const PG8_LAS bf16x8*)(lds + PG8_SA(b, h) + aoff + m * 2048 + k * 1024); } while (0)
#define PG8_LDB(dst, b, h) do { _Pragma("unroll") for (int n = 0; n < 2; ++n) _Pragma("unroll") for (int k = 0; k < 2; ++k) dst[n][k] = *(const PG8_LAS bf16x8*)(lds + PG8_SB(b, h) + boff + n * 2048 + k * 1024); } while (0)
#define PG8_MMA(ai, bj, At, Bt) do { __builtin_amdgcn_s_setprio(1); _Pragma("unroll") for (int m = 0; m < 4; ++m) _Pragma("unroll") for (int n = 0; n < 2; ++n) _Pragma("unroll") for (int k = 0; k < 2; ++k) \
        acc[ai][bj][m][n] = __builtin_amdgcn_mfma_f32_16x16x32_bf16(Bt[n][k], At[m][k], acc[ai][bj][m][n], 0, 0, 0); __builtin_amdgcn_s_setprio(0); } while (0)
#define PG8_WAIT_V(n) asm volatile("s_waitcnt vmcnt(" #n ")" ::: "memory")
#define PG8_WAIT_L(n) asm volatile("s_waitcnt lgkmcnt(" #n ")" ::: "memory")
#define PG8_BAR __builtin_amdgcn_s_barrier()
#define PG8_SCHED __builtin_amdgcn_sched_barrier(0)
    Unit cur, nxt; int ui = 0;
    if (!S.next(0, cur)) return;
    f32x4 acc[2][2][4][2];
#pragma unroll
    for (int a = 0; a < 2; ++a)
#pragma unroll
        for (int b = 0; b < 2; ++b)
#pragma unroll
            for (int m = 0; m < 4; ++m)
#pragma unroll
                for (int n = 0; n < 2; ++n) acc[a][b][m][n] = (f32x4){0.f, 0.f, 0.f, 0.f};
    bf16x8 At[4][2], B0[2][2], B1[2][2];
    const char* cA = (const char*)g.A + (size_t)cur.pm * tstep; const char* cB = (const char*)g.Bt + (size_t)cur.pn * tstep;
    S.a_ready(cur);
    if constexpr (SP2) {
        PG8_STAGE(PG8_SB(0, 0), cB, voffB); PG8_STAGE(PG8_SB(0, 1), cB + hstep, voffB); PG8_STAGE(PG8_SA(0, 0), cA, voffA); PG8_STAGE(PG8_SA(0, 1), cA + hstep, voffA);
        if (wr == 1) PG8_BAR;
        PG8_WAIT_V(2); PG8_BAR;
        PG8_STAGE(PG8_SB(1, 0), cB + kstep, voffB); PG8_STAGE(PG8_SA(1, 0), cA + kstep, voffA); PG8_STAGE(PG8_SB(1, 1), cB + hstep + kstep, voffB);
        PG8_WAIT_V(6); PG8_BAR;
    } else {
        PG8_STAGE(PG8_SB(0, 0), cB, voffB); PG8_STAGE(PG8_SA(0, 0), cA, voffA); PG8_STAGE(PG8_SB(0, 1), cB + hstep, voffB); PG8_STAGE(PG8_SA(0, 1), cA + hstep, voffA);
        if (wr == 1) PG8_BAR;
        PG8_WAIT_V(4); PG8_BAR;
        PG8_STAGE(PG8_SB(1, 0), cB + kstep, voffB); PG8_STAGE(PG8_SA(1, 0), cA + kstep, voffA); PG8_STAGE(PG8_SB(1, 1), cB + hstep + kstep, voffB);
        PG8_WAIT_V(6); PG8_BAR;
    }
    for (;;) {
        const bool has_next = S.next(ui + 1, nxt);
        const char* nA = has_next ? (const char*)g.A + (size_t)nxt.pm * tstep : cA; const char* nB = has_next ? (const char*)g.Bt + (size_t)nxt.pn * tstep : cB;
        for (int t = 0; t < nt; t += 2) {
            const bool last = (t == nt - 2);
            const char* a1 = cA + (size_t)(t + 1) * kstep;
            const char* a2 = last ? nA : cA + (size_t)(t + 2) * kstep; const char* b2 = last ? nB : cB + (size_t)(t + 2) * kstep;
            const char* a3 = a2 + kstep; const char* b3 = b2 + kstep;
            if (last && has_next) S.a_ready(nxt);
            if constexpr (SP2) {
            PG8_LDB(B0, 0, 0); PG8_LDB(B1, 0, 1); PG8_SCHED; PG8_LDA(At, 0, 0); PG8_STAGE(PG8_SA(1, 1), a1 + hstep, voffA);
            PG8_WAIT_V(8); PG8_WAIT_L(0); PG8_BAR; PG8_MMA(0, 0, At, B0); PG8_MMA(0, 1, At, B1); PG8_BAR; PG8_SCHED;
            PG8_LDA(At, 0, 1); PG8_STAGE(PG8_SB(0, 0), b2, voffB); PG8_STAGE(PG8_SB(0, 1), b2 + hstep, voffB); PG8_STAGE(PG8_SA(0, 0), a2, voffA);
            PG8_WAIT_V(8); PG8_WAIT_L(0); PG8_BAR; PG8_MMA(1, 0, At, B0); PG8_MMA(1, 1, At, B1); PG8_BAR; PG8_SCHED;
            PG8_LDB(B0, 1, 0); PG8_LDB(B1, 1, 1); PG8_SCHED; PG8_LDA(At, 1, 0); PG8_STAGE(PG8_SA(0, 1), a2 + hstep, voffA);
            PG8_WAIT_V(8); PG8_WAIT_L(0); PG8_BAR; PG8_MMA(0, 0, At, B0); PG8_MMA(0, 1, At, B1); PG8_BAR; PG8_SCHED;
            PG8_LDA(At, 1, 1); PG8_STAGE(PG8_SB(1, 0), b3, voffB); PG8_STAGE(PG8_SB(1, 1), b3 + hstep, voffB); PG8_STAGE(PG8_SA(1, 0), a3, voffA);
            PG8_WAIT_V(8); PG8_WAIT_L(0); PG8_BAR; PG8_MMA(1, 0, At, B0); PG8_MMA(1, 1, At, B1); PG8_BAR; PG8_SCHED;
            } else {
            PG8_LDB(B0, 0, 0); PG8_SCHED; PG8_LDA(At, 0, 0); PG8_STAGE(PG8_SA(1, 1), a1 + hstep, voffA);
            PG8_WAIT_L(8); PG8_BAR; PG8_WAIT_L(0); PG8_MMA(0, 0, At, B0); PG8_BAR; PG8_SCHED;
            PG8_LDB(B1, 0, 1); PG8_STAGE(PG8_SB(0, 0), b2, voffB);
            PG8_BAR; PG8_WAIT_L(0); PG8_MMA(0, 1, At, B1); PG8_BAR;
            PG8_LDA(At, 0, 1); PG8_STAGE(PG8_SA(0, 0), a2, voffA);
            PG8_BAR; PG8_WAIT_L(0); PG8_MMA(1, 0, At, B0); PG8_BAR; PG8_SCHED;
            PG8_STAGE(PG8_SB(0, 1), b2 + hstep, voffB);
            PG8_WAIT_V(6); PG8_BAR; PG8_MMA(1, 1, At, B1); PG8_BAR;
            PG8_LDB(B0, 1, 0); PG8_SCHED; PG8_LDA(At, 1, 0); PG8_STAGE(PG8_SA(0, 1), a2 + hstep, voffA);
            PG8_WAIT_L(8); PG8_BAR; PG8_WAIT_L(0); PG8_MMA(0, 0, At, B0); PG8_BAR; PG8_SCHED;
            PG8_LDB(B1, 1, 1); PG8_STAGE(PG8_SB(1, 0), b3, voffB);
            PG8_BAR; PG8_WAIT_L(0); PG8_MMA(0, 1, At, B1); PG8_BAR;
            PG8_LDA(At, 1, 1); PG8_STAGE(PG8_SA(1, 0), a3, voffA);
            PG8_BAR; PG8_WAIT_L(0); PG8_MMA(1, 0, At, B0); PG8_BAR; PG8_SCHED;
            PG8_STAGE(PG8_SB(1, 1), b3 + hstep, voffB);
            PG8_WAIT_V(6); PG8_BAR; PG8_MMA(1, 1, At, B1); PG8_BAR;
            }
        }
        if constexpr (ALIGN_EPI) { if (wr == 0) PG8_BAR; }
        if constexpr (!Epi::AFTER_DRAIN) { E(acc, cur, wr, wc, fr, fq); S.done(cur); }
        if (!has_next) break;
#pragma unroll
        for (int a = 0; a < 2; ++a)
#pragma unroll
            for (int b = 0; b < 2; ++b)
#pragma unroll
                for (int m = 0; m < 4; ++m)
#pragma unroll
                    for (int n = 0; n < 2; ++n) acc[a][b][m][n] = (f32x4){0.f, 0.f, 0.f, 0.f};
        cur = nxt; cA = nA; cB = nB; ++ui;
        if constexpr (ALIGN_EPI) { if (wr == 1) PG8_BAR; }
    }
    PG8_WAIT_V(0);
    if constexpr (!ALIGN_EPI) { if (wr == 0) PG8_BAR; }
    PG8_BAR;
    if constexpr (Epi::AFTER_DRAIN) { E.fused(acc, cur, wr, wc, fr, fq, lds, wid, lane); S.done(cur); }
#undef PG8_SA
#undef PG8_SB
#undef PG8_STAGE
#undef PG8_LDA
#undef PG8_LDB
#undef PG8_MMA
#undef PG8_WAIT_V
#undef PG8_WAIT_L
#undef PG8_BAR
#undef PG8_SCHED
}
}

#define LAS __attribute__((address_space(3)))
typedef unsigned short bf16_t;
typedef short bf16x8 __attribute__((ext_vector_type(8)));
typedef short s16x4 __attribute__((ext_vector_type(4)));
typedef float f32x4 __attribute__((ext_vector_type(4)));
typedef float f32x16 __attribute__((ext_vector_type(16)));
typedef unsigned u32x4 __attribute__((ext_vector_type(4)));
typedef unsigned u32x2 __attribute__((ext_vector_type(2)));

constexpr int SEQ = 8192, DM = 2048, MTOK = 16384, DFF = 5632, NQKV = 6144, HD = 128;
constexpr size_t SZ_WIN = (size_t)2 * DFF * DM * 2, SZ_WOUT = (size_t)DM * DFF * 2, SZ_WMIN = (size_t)NQKV * DM * 2, SZ_WMOUT = (size_t)DM * DM * 2;
constexpr size_t WS_FFA_IN = 0, WS_FFA_OUT = WS_FFA_IN + 2 * SZ_WIN, WS_FFB_IN = WS_FFA_OUT + 2 * SZ_WOUT, WS_FFB_OUT = WS_FFB_IN + 2 * SZ_WIN;
constexpr size_t WS_MIX_IN = WS_FFB_OUT + 2 * SZ_WOUT, WS_MIX_OUT = WS_MIX_IN + 2 * SZ_WMIN;
constexpr size_t WS_XN = WS_MIX_OUT + 2 * SZ_WMOUT;
constexpr size_t WS_BIG = WS_XN + (size_t)MTOK * DM * 2;
constexpr size_t WS_ATT = WS_BIG + (size_t)MTOK * NQKV * 2;
constexpr size_t WS_PART = WS_ATT + (size_t)MTOK * DM * 2;
constexpr size_t WS_LSE = WS_PART + (size_t)3 * MTOK * 1024 * 2;
constexpr size_t WS_ROPE = WS_LSE + (size_t)3 * MTOK * 8 * 4;
constexpr size_t WS_KMEAN = WS_ROPE + (size_t)2 * SEQ * 64 * 4;
constexpr size_t WS_CTL = WS_KMEAN + (size_t)2 * 8 * 32 * 128 * 4, CTL_BYTES = 16384;
constexpr size_t WS_END = WS_CTL + CTL_BYTES;

#ifndef REP_ATT
#define REP_ATT 1
#endif
#ifndef REP_DIL
#define REP_DIL REP_ATT
#endif
#ifndef REP_MOBA
#define REP_MOBA REP_ATT
#endif
#ifndef REP_DIFF
#define REP_DIFF REP_ATT
#endif
#ifndef REP_PRO
#define REP_PRO 1
#endif
#ifndef REP_SWI
#define REP_SWI 1
#endif
#ifndef REP_QKV
#define REP_QKV 1
#endif
#ifndef REP_NORM
#define REP_NORM 1
#endif
#ifndef REP_RES
#define REP_RES 1
#endif
#ifndef REP_SYNC
#define REP_SYNC 1
#endif
#define GSYNC() do { for (int rs_ = 0; rs_ < REP_SYNC; ++rs_) { int l_; asm volatile("v_mbcnt_lo_u32_b32 %0, -1, 0\n\tv_mbcnt_hi_u32_b32 %0, -1, %0" : "=v"(l_)); xcd_barrier(xbar, (l_ + wave_s * 64) == 0); } } while (0)
constexpr int LDS_BYTES = 153600;

struct Params {
    const float* in[18];
    float* out; unsigned char* ws;
};

__device__ __forceinline__ unsigned f2bf(float f) { unsigned u = __builtin_bit_cast(unsigned, f); return (u + 0x7fffu + ((u >> 16) & 1u)) >> 16; }
__device__ __forceinline__ unsigned pk2(float lo, float hi) { return f2bf(lo) | (f2bf(hi) << 16); }
__device__ __forceinline__ float bf2f(unsigned short b) { return __builtin_bit_cast(float, (unsigned)b << 16); }
__device__ __forceinline__ int shfl_xor_i(int v, int o, int lane) { return __builtin_amdgcn_ds_bpermute((lane ^ o) << 2, v); }
__device__ __forceinline__ float shfl_xor_f(float v, int o, int lane) { return __int_as_float(__builtin_amdgcn_ds_bpermute((lane ^ o) << 2, __float_as_int(v))); }
__device__ __forceinline__ float wave_sum(float v, int lane) {
#pragma unroll
    for (int o = 1; o < 64; o <<= 1) v += shfl_xor_f(v, o, lane);
    return v;
}

template <int MODE>
__device__ __forceinline__ int src_col(int n, unsigned long long ropemask) {
    if (MODE == 0) return n;
    if (MODE == 1) { const int pn = n >> 8, cc = n & 255; return cc < 128 ? pn * 128 + cc : DFF + pn * 128 + (cc - 128); }
    const int hg = n >> 7, p = n & 127;
    if ((ropemask >> hg) & 1ull) return hg * 128 + ((p & 1) ? 64 + (p >> 1) : (p >> 1));
    return n;
}
template <int MODE>
__device__ __forceinline__ void transpose_items(const float* W, int K, int N, bf16_t* WT, unsigned long long ropemask, LAS float* scr, int gw, int NGW, int lane) {
    const int nblk = N / 32, nitems = (K / 64) * nblk;
    for (int item = gw; item < nitems; item += NGW) {
        const int kb = item / nblk, nb = item % nblk, k0 = 64 * kb, n0 = 32 * nb;
        const int sc = src_col<MODE>(n0 + (lane & 31), ropemask);
#pragma unroll
        for (int i = 0; i < 32; ++i) { const int kk = 2 * i + (lane >> 5); scr[kk * 33 + (lane & 31)] = W[(size_t)(k0 + kk) * N + sc]; }
        asm volatile("s_waitcnt lgkmcnt(0)" ::: "memory");
        const int c = lane & 7;
#pragma unroll
        for (int j = 0; j < 4; ++j) { const int n = (lane >> 3) + 8 * j; const LAS float* s = scr + (8 * c) * 33 + n;
            u32x4 o; o.x = pk2(s[0 * 33], s[1 * 33]); o.y = pk2(s[2 * 33], s[3 * 33]); o.z = pk2(s[4 * 33], s[5 * 33]); o.w = pk2(s[6 * 33], s[7 * 33]);
            *(u32x4*)(WT + (size_t)(n0 + n) * K + k0 + 8 * c) = o; }
        asm volatile("s_waitcnt lgkmcnt(0)" ::: "memory");
    }
}

template <bool OUT_F32>
__device__ __forceinline__ void norm_phase(const float* src, const float* gain, void* dst, int gw, int NGW, int lane) {
    f32x4 g[8];
#pragma unroll
    for (int j = 0; j < 8; ++j) g[j] = ((const f32x4*)gain)[lane + 64 * j];
    for (int row = gw; row < MTOK; row += 2 * NGW) {
        const f32x4* xr0 = (const f32x4*)(src + (size_t)row * DM) + lane;
        const int rowb = (row + NGW < MTOK) ? row + NGW : row;
        const f32x4* xr1 = (const f32x4*)(src + (size_t)rowb * DM) + lane;
        f32x4 v0[8], v1[8]; float s0 = 0.f, s1 = 0.f;
#pragma unroll
        for (int j = 0; j < 8; ++j) { v0[j] = xr0[64 * j]; v1[j] = xr1[64 * j]; }
#pragma unroll
        for (int j = 0; j < 8; ++j) { s0 += (v0[j].x * v0[j].x + v0[j].y * v0[j].y) + (v0[j].z * v0[j].z + v0[j].w * v0[j].w); s1 += (v1[j].x * v1[j].x + v1[j].y * v1[j].y) + (v1[j].z * v1[j].z + v1[j].w * v1[j].w); }
        const float r0 = 1.0f / sqrtf(wave_sum(s0, lane) * (1.0f / DM) + 1e-6f), r1 = 1.0f / sqrtf(wave_sum(s1, lane) * (1.0f / DM) + 1e-6f);
        if (OUT_F32) { f32x4* o0 = (f32x4*)((float*)dst + (size_t)row * DM) + lane; f32x4* o1 = (f32x4*)((float*)dst + (size_t)rowb * DM) + lane;
#pragma unroll
            for (int j = 0; j < 8; ++j) { o0[64 * j] = v0[j] * r0 * g[j]; o1[64 * j] = v1[j] * r1 * g[j]; }
        } else { u32x2* o0 = (u32x2*)((bf16_t*)dst + (size_t)row * DM) + lane; u32x2* o1 = (u32x2*)((bf16_t*)dst + (size_t)rowb * DM) + lane;
#pragma unroll
            for (int j = 0; j < 8; ++j) { const f32x4 y0 = v0[j] * r0 * g[j], y1 = v1[j] * r1 * g[j]; u32x2 w0, w1; w0.x = pk2(y0.x, y0.y); w0.y = pk2(y0.z, y0.w); w1.x = pk2(y1.x, y1.y); w1.y = pk2(y1.z, y1.w); o0[64 * j] = w0; o1[64 * j] = w1; } }
    }
}

namespace att {
constexpr int KSTR = 272, VSTR = 320, KBYTES = 64 * KSTR, VBYTES = 64 * VSTR;
constexpr float SC = 0.08838834764831845f * 1.4426950408889634f;
constexpr float NEG = -1e30f;
constexpr float NEGR = -1e6f;
__device__ __forceinline__ int crow(int e, int hi) { return (e & 3) + 8 * (e >> 2) + 4 * hi; }
typedef float f32x2_t __attribute__((ext_vector_type(2))); typedef __bf16 bf16x2_t __attribute__((ext_vector_type(2)));
__device__ __forceinline__ unsigned cvtpk(float lo, float hi) { f32x2_t v = {lo, hi}; bf16x2_t b = __builtin_convertvector(v, bf16x2_t); return __builtin_bit_cast(unsigned, b); }
__device__ __forceinline__ float xhalf_max(float v) { auto rr = __builtin_amdgcn_permlane32_swap(__float_as_uint(v), __float_as_uint(v), false, false); return fmaxf(__uint_as_float(rr[0]), __uint_as_float(rr[1])); }
__device__ __forceinline__ float xhalf_sum(float v) { auto rr = __builtin_amdgcn_permlane32_swap(__float_as_uint(v), __float_as_uint(v), false, false); return __uint_as_float(rr[0]) + __uint_as_float(rr[1]); }
__device__ __forceinline__ float max3f(float a, float b, float c) { float r; asm("v_max3_f32 %0, %1, %2, %3" : "=v"(r) : "v"(a), "v"(b), "v"(c)); return r; }
__device__ __forceinline__ float max2f(float a, float b) { float r; asm("v_max_f32_e32 %0, %1, %2" : "=v"(r) : "v"(a), "v"(b)); return r; }
__device__ __forceinline__ float fadd_s(float a, float b) { float r; asm("v_add_f32_e32 %0, %1, %2" : "=v"(r) : "v"(a), "v"(b)); return r; }
__device__ __forceinline__ bf16x8 pack8(const f32x16& s, int o) {
    u32x4 w; w.x = cvtpk(s[o + 0], s[o + 1]); w.y = cvtpk(s[o + 2], s[o + 3]); w.z = cvtpk(s[o + 4], s[o + 5]); w.w = cvtpk(s[o + 6], s[o + 7]);
    return __builtin_bit_cast(bf16x8, w);
}
__device__ __forceinline__ s16x4 vtr(const LAS unsigned char* p) { return __builtin_bit_cast(s16x4, __builtin_amdgcn_ds_read_tr16_b64_v4i16((LAS s16x4*)p)); }

__device__ __forceinline__ void load_q(bf16x8 (&qf)[8], const bf16_t* Qp, long qrow, int hi) {
    const bf16_t* p = Qp + qrow * NQKV + 8 * hi;
#pragma unroll
    for (int c = 0; c < 8; ++c) qf[c] = *(const bf16x8*)(p + 16 * c);
}

#ifndef PF_AHEAD
#define PF_AHEAD 3
#endif
struct Stage { u32x4 kreg[2], vreg[2]; };
template <class TS>
__device__ __forceinline__ void m_block(LAS unsigned char* lds, const TS& ts, int tau, int nt, const bf16x8 (&qf)[8], f32x16 (&O)[4], f32x16& s0, f32x16& s1, const bf16x8 (&P)[4], int kro, int vro) {
#pragma unroll
    for (int e = 0; e < 16; ++e) { s0[e] = 0.f; s1[e] = 0.f; }
#ifdef PROBE_MFMA2
    f32x16 dmy;
#pragma unroll
    for (int e = 0; e < 16; ++e) dmy[e] = 0.f;
#endif
    const bool qk_on = tau + 1 < nt && ts.active(tau + 1);
    const LAS unsigned char* kb = lds + ((tau + 1) & 1) * KBYTES + kro;
    bf16x8 fk[2][4];
    if (qk_on) {
#pragma unroll
        for (int j = 0; j < 2; ++j) { fk[0][2 * j] = *(const LAS bf16x8*)(kb + j * 32); fk[0][2 * j + 1] = *(const LAS bf16x8*)(kb + 32 * KSTR + j * 32); }
    }
    __builtin_amdgcn_sched_barrier(0);
    if (tau >= 0 && ts.active(tau)) {
        const LAS unsigned char* vb = lds + 2 * KBYTES + (tau & 1) * VBYTES + vro;
        s16x4 fl[2][4], fh[2][4];
#pragma unroll
        for (int b = 0; b < 4; ++b) { fl[0][b] = vtr(vb + b * 64); fh[0][b] = vtr(vb + 8 * VSTR + b * 64); }
        __builtin_amdgcn_sched_barrier(0);
#pragma unroll
        for (int q = 0; q < 4; ++q) {
            if (q < 3) {
#pragma unroll
                for (int b = 0; b < 4; ++b) { fl[(q + 1) & 1][b] = vtr(vb + (16 * (q + 1)) * VSTR + b * 64); fh[(q + 1) & 1][b] = vtr(vb + (16 * (q + 1) + 8) * VSTR + b * 64); }
            }
#pragma unroll
            for (int b = 0; b < 4; ++b) {
                const s16x4 lo = fl[q & 1][b], hh = fh[q & 1][b];
                const bf16x8 vf = (bf16x8){lo[0], lo[1], lo[2], lo[3], hh[0], hh[1], hh[2], hh[3]};
                O[b] = __builtin_amdgcn_mfma_f32_32x32x16_bf16(vf, P[q], O[b], 0, 0, 0);
#ifdef PROBE_MFMA2
                dmy = __builtin_amdgcn_mfma_f32_32x32x16_bf16(vf, P[q], dmy, 0, 0, 0);
#endif
            }
            __builtin_amdgcn_sched_barrier(0);
        }
    }
    if (qk_on) {
#pragma unroll
        for (int c2 = 0; c2 < 4; ++c2) {
            if (c2 < 3) {
#pragma unroll
                for (int j = 0; j < 2; ++j) { fk[(c2 + 1) & 1][2 * j] = *(const LAS bf16x8*)(kb + (2 * (c2 + 1) + j) * 32); fk[(c2 + 1) & 1][2 * j + 1] = *(const LAS bf16x8*)(kb + 32 * KSTR + (2 * (c2 + 1) + j) * 32); }
            }
#pragma unroll
            for (int j = 0; j < 2; ++j) {
                s0 = __builtin_amdgcn_mfma_f32_32x32x16_bf16(fk[c2 & 1][2 * j], qf[2 * c2 + j], s0, 0, 0, 0);
                s1 = __builtin_amdgcn_mfma_f32_32x32x16_bf16(fk[c2 & 1][2 * j + 1], qf[2 * c2 + j], s1, 0, 0, 0);
#ifdef PROBE_MFMA2
                dmy = __builtin_amdgcn_mfma_f32_32x32x16_bf16(fk[c2 & 1][2 * j], qf[2 * c2 + j], dmy, 0, 0, 0);
                dmy = __builtin_amdgcn_mfma_f32_32x32x16_bf16(fk[c2 & 1][2 * j + 1], qf[2 * c2 + j], dmy, 0, 0, 0);
#endif
            }
            __builtin_amdgcn_sched_barrier(0);
        }
    }
#ifdef PROBE_MFMA2
    asm volatile("" :: "v"(dmy));
#endif
}
template <class TS>
__device__ __forceinline__ void v_block(LAS unsigned char* lds, const TS& ts, int tau, int ct, int nt, const bf16_t* Kp, const bf16_t* Vp, long krow0, int kstride, Stage& st,
                                        f32x16 (&O)[4], f32x16& s0, f32x16& s1, bf16x8 (&P)[4], float& m, float& l, int sr, int sc16, int hi) {
    asm volatile("" : "+v"(sr), "+v"(sc16));
#define ATT_ROW(t_, i_) ({ int kp_ = ts.kstart(t_) + sr + 32 * (i_); if (TS::CLAMP) kp_ = kp_ < 0 ? 0 : kp_; ((unsigned)((int)krow0 + kp_ * kstride) * (unsigned)NQKV + (unsigned)(sc16 * 8)) * 2u; })
#define ATT_ISSUE_K(t_) do { if ((t_) >= 0 && (t_) < nt) { _Pragma("unroll") for (int i_ = 0; i_ < 2; ++i_) st.kreg[i_] = *(const u32x4*)((const char*)Kp + ATT_ROW(t_, i_)); } } while (0)
#define ATT_ISSUE_V(t_) do { if ((t_) >= 0 && (t_) < nt) { _Pragma("unroll") for (int i_ = 0; i_ < 2; ++i_) st.vreg[i_] = *(const u32x4*)((const char*)Vp + ATT_ROW(t_, i_)); } } while (0)
#define ATT_COMMIT_K(t_) do { if ((t_) >= 0 && (t_) < nt) { _Pragma("unroll") for (int i_ = 0; i_ < 2; ++i_) *(LAS u32x4*)(lds + ((t_) & 1) * KBYTES + (sr + 32 * i_) * KSTR + sc16 * 16) = st.kreg[i_]; } } while (0)
#define ATT_COMMIT_V(t_) do { if ((t_) >= 0 && (t_) < nt) { _Pragma("unroll") for (int i_ = 0; i_ < 2; ++i_) *(LAS u32x4*)(lds + 2 * KBYTES + ((t_) & 1) * VBYTES + (sr + 32 * i_) * VSTR + sc16 * 16) = st.vreg[i_]; } } while (0)
    ATT_COMMIT_K(ct); ATT_COMMIT_V(ct - 1);
    ATT_ISSUE_K(ct + 1); ATT_ISSUE_V(ct);
#ifdef USE_L2_PREFETCH
    if ((sc16 & 7) == 0) {
        if (ct + 1 + PF_AHEAD < nt) { _Pragma("unroll") for (int i_ = 0; i_ < 2; ++i_) (void)*(const volatile unsigned*)((const char*)Kp + ATT_ROW(ct + 1 + PF_AHEAD, i_)); }
        if (ct + PF_AHEAD < nt && ct + PF_AHEAD >= 0) { _Pragma("unroll") for (int i_ = 0; i_ < 2; ++i_) (void)*(const volatile unsigned*)((const char*)Vp + ATT_ROW(ct + PF_AHEAD, i_)); }
    }
#endif
    const int t = tau + 1;
    if (t >= 0 && t < nt && ts.active(t)) {
        __builtin_amdgcn_s_setprio(1);
        const int ks = ts.kstart(t);
        if (ts.need_mask(t)) {
#pragma unroll
            for (int e = 0; e < 16; ++e) {
                const int kp0 = ks + crow(e, hi), kp1 = kp0 + 32;
                s0[e] = ts.valid(t, ks, kp0) ? s0[e] : NEGR; s1[e] = ts.valid(t, ks, kp1) ? s1[e] : NEGR;
            }
        }
        float mxa = max3f(s0[0], s0[1], s1[0]), mxb = max3f(s0[2], s0[3], s1[1]);
        mxa = max3f(mxa, s1[2], s1[3]);
#pragma unroll
        for (int e = 4; e < 16; e += 4) { mxa = max3f(mxa, s0[e], s0[e + 1]); mxb = max3f(mxb, s0[e + 2], s0[e + 3]); mxa = max3f(mxa, s1[e], s1[e + 1]); mxb = max3f(mxb, s1[e + 2], s1[e + 3]); }
        float mx = max2f(mxa, mxb);
        mx = xhalf_max(mx);
        const float mn = max2f(m, mx * SC);
        if (__any(mn > m)) {
            const float a = __builtin_amdgcn_exp2f(m - mn); l *= a; m = mn;
#pragma unroll
            for (int b = 0; b < 4; ++b)
#pragma unroll
                for (int e = 0; e < 16; ++e) O[b][e] *= a;
        }
        float ps = 0.f, ps1 = 0.f;
#pragma unroll
        for (int e = 0; e < 16; ++e) { s0[e] = __builtin_amdgcn_exp2f(__builtin_fmaf(s0[e], SC, -m)); s1[e] = __builtin_amdgcn_exp2f(__builtin_fmaf(s1[e], SC, -m)); ps += s0[e]; ps1 += s1[e]; }
        l += ps + ps1;
#ifdef PROBE_EXP2
        { float d2 = 0.f;
#pragma unroll
          for (int e = 0; e < 16; ++e) d2 += __builtin_amdgcn_exp2f(s0[e] * 0.5f) + __builtin_amdgcn_exp2f(s1[e] * 0.5f);
          asm volatile("" :: "v"(d2)); }
#endif
        P[0] = pack8(s0, 0); P[1] = pack8(s0, 8); P[2] = pack8(s1, 0); P[3] = pack8(s1, 8);
        __builtin_amdgcn_s_setprio(0);
    }
}
template <class TS>
__device__ __forceinline__ void flash_pass(LAS unsigned char* lds, const bf16_t* Kp, const bf16_t* Vp, long krow0, int kstride,
                                           const bf16x8 (&qf)[8], const TS& ts, f32x16 (&O)[4], float& m, float& l, const int tid) {
#define ATT_BAR() do { asm volatile("s_waitcnt lgkmcnt(0)" ::: "memory"); __builtin_amdgcn_s_barrier(); asm volatile("" ::: "memory"); } while (0)
    const int lane = tid & 63, hi = lane >> 5, grp = __builtin_amdgcn_readfirstlane(tid >> 8);
    const int sr = tid >> 4, sc16 = tid & 15;
    Stage st;
    const int nt = ts.n();
    ATT_ISSUE_K(0); ATT_COMMIT_K(0); ATT_ISSUE_K(1); ATT_ISSUE_V(0);
    ATT_BAR();
    const int kro = (lane & 31) * KSTR + hi * 16;
    const int vro = (4 * hi + ((lane & 15) >> 2)) * VSTR + (((lane >> 4) & 1) * 16 + (lane & 3) * 4) * 2;
    f32x16 s0, s1; bf16x8 P[4];
#pragma unroll
    for (int q = 0; q < 4; ++q) P[q] = (bf16x8){0, 0, 0, 0, 0, 0, 0, 0};
    if (grp == 0) {
        for (int tau = -1; tau < nt; ++tau) {
            m_block(lds, ts, tau, nt, qf, O, s0, s1, P, kro, vro);
            v_block(lds, ts, tau, tau + 2, nt, Kp, Vp, krow0, kstride, st, O, s0, s1, P, m, l, sr, sc16, hi);
            ATT_BAR();
        }
    } else {
        for (int tau = -1; tau < nt; ++tau) {
            v_block(lds, ts, tau - 1, tau + 2, nt, Kp, Vp, krow0, kstride, st, O, s0, s1, P, m, l, sr, sc16, hi);
            m_block(lds, ts, tau, nt, qf, O, s0, s1, P, kro, vro);
            ATT_BAR();
        }
    }
#undef ATT_BAR
#undef ATT_ROW
#undef ATT_ISSUE_K
#undef ATT_ISSUE_V
#undef ATT_COMMIT_K
#undef ATT_COMMIT_V
}

__device__ __forceinline__ void zero_state(f32x16 (&O)[4], float& m, float& l) {
#pragma unroll
    for (int b = 0; b < 4; ++b)
#pragma unroll
        for (int e = 0; e < 16; ++e) O[b][e] = 0.f;
    m = NEG; l = 0.f;
}
__device__ __forceinline__ void store_o(const f32x16 (&O)[4], float scale, bf16_t* dst, int hi) {
#pragma unroll
    for (int b = 0; b < 4; ++b)
#pragma unroll
        for (int g = 0; g < 4; ++g) { u32x2 w; w.x = cvtpk(O[b][4 * g] * scale, O[b][4 * g + 1] * scale); w.y = cvtpk(O[b][4 * g + 2] * scale, O[b][4 * g + 3] * scale);
            *(u32x2*)(dst + 32 * b + 8 * g + 4 * hi) = w; }
}

struct TSDil {
    static constexpr bool CLAMP = true;
    int k0, qlo, qpos;
    __device__ __forceinline__ int n() const { return 6; }
    __device__ __forceinline__ int kstart(int t) const { return k0 + 64 * t; }
    __device__ __forceinline__ bool active(int t) const { const int ks = k0 + 64 * t; return ks <= qlo + 31 && ks + 63 >= qlo - 128; }
    __device__ __forceinline__ bool need_mask(int) const { return true; }
    __device__ __forceinline__ bool valid(int, int, int kpos) const { const int d = qpos - kpos; return d >= 0 && d <= 128 && kpos >= 0; }
};
struct TSCausal {
    static constexpr bool CLAMP = false;
    int nt, qpos, wqhi;
    __device__ __forceinline__ int n() const { return nt; }
    __device__ __forceinline__ int kstart(int t) const { return 64 * t; }
    __device__ __forceinline__ bool active(int t) const { return 64 * t <= wqhi; }
    __device__ __forceinline__ bool need_mask(int t) const { return 64 * t + 63 > wqhi - 31; }
    __device__ __forceinline__ bool valid(int, int, int kpos) const { return kpos <= qpos; }
};
struct TSMoba {
    static constexpr bool CLAMP = false;
    const LAS int* list; int nt, qb, qpos, wqhi; unsigned wmask, lmask, amask;
    __device__ __forceinline__ int n() const { return nt; }
    __device__ __forceinline__ int kstart(int t) const { return list[t]; }
    __device__ __forceinline__ bool active(int t) const { const int ks = list[t], blk = ks >> 8; return blk == qb ? ks <= wqhi : ((wmask >> blk) & 1u) != 0u; }
    __device__ __forceinline__ bool need_mask(int t) const { const int ks = list[t], blk = ks >> 8; return blk == qb ? ks + 63 > wqhi - 31 : ((amask >> blk) & 1u) == 0u; }
    __device__ __forceinline__ bool valid(int, int ks, int kpos) const { const int blk = ks >> 8; return blk == qb ? kpos <= qpos : ((lmask >> blk) & 1u) != 0u; }
};

constexpr int VS2 = 576, VB2 = 64 * VS2, DP_V = 2 * KBYTES, DP_P = DP_V + 2 * VB2, DP_PW = 5120, DP_PSLOT = 4 * DP_PW, DP_END = DP_P + 2 * DP_PSLOT;
__device__ __forceinline__ void diff_pass(LAS unsigned char* lds, const bf16_t* Kp, const bf16_t* Vp, const bf16_t* Qp, const int row0, const int qb, f32x16 (&O)[4], float& inv_l, const int tid) {
#define DP_BAR() do { asm volatile("s_waitcnt lgkmcnt(0)" ::: "memory"); __builtin_amdgcn_s_barrier(); asm volatile("" ::: "memory"); } while (0)
    const int lane = tid & 63, hi = lane >> 5, grp = __builtin_amdgcn_readfirstlane(tid >> 8), pw = __builtin_amdgcn_readfirstlane(tid >> 6) & 3;
    const int nt = 2 * (qb + 1), qlo = 128 * qb + 32 * pw, qpos = qlo + (lane & 31), wqhi = qlo + 31;
    LAS unsigned char* pbase = lds + DP_P + pw * DP_PW + lane * 16;
    const int vro = (4 * hi + ((lane & 15) >> 2)) * VS2 + (((lane >> 4) & 1) * 16 + (lane & 3) * 4) * 2 + grp * 256;
#pragma unroll
    for (int b = 0; b < 4; ++b)
#pragma unroll
        for (int e = 0; e < 16; ++e) O[b][e] = 0.f;
#define DP_PV(tau_, Pf_) do { const LAS unsigned char* vb_ = lds + DP_V + ((tau_) & 1) * VB2 + vro; s16x4 fl_[2][4], fh_[2][4]; \
        _Pragma("unroll") for (int b_ = 0; b_ < 4; ++b_) { fl_[0][b_] = vtr(vb_ + b_ * 64); fh_[0][b_] = vtr(vb_ + 8 * VS2 + b_ * 64); } \
        __builtin_amdgcn_sched_barrier(0); \
        _Pragma("unroll") for (int q_ = 0; q_ < 4; ++q_) { \
            if (q_ < 3) { _Pragma("unroll") for (int b_ = 0; b_ < 4; ++b_) { fl_[(q_ + 1) & 1][b_] = vtr(vb_ + (16 * (q_ + 1)) * VS2 + b_ * 64); fh_[(q_ + 1) & 1][b_] = vtr(vb_ + (16 * (q_ + 1) + 8) * VS2 + b_ * 64); } } \
            _Pragma("unroll") for (int b_ = 0; b_ < 4; ++b_) { const s16x4 lo_ = fl_[q_ & 1][b_], hh_ = fh_[q_ & 1][b_]; \
                const bf16x8 vf_ = (bf16x8){lo_[0], lo_[1], lo_[2], lo_[3], hh_[0], hh_[1], hh_[2], hh_[3]}; \
                O[b_] = __builtin_amdgcn_mfma_f32_32x32x16_bf16(vf_, Pf_[q_], O[b_], 0, 0, 0); } \
            __builtin_amdgcn_sched_barrier(0); } } while (0)
    if (grp == 0) {
        int sr = tid >> 4, sc16 = tid & 15;
        u32x4 kreg[4];
#define DP_KOFF(t_, i_) (((unsigned)(row0 + 64 * (t_) + sr + 16 * (i_)) * (unsigned)NQKV + (unsigned)(sc16 * 8)) * 2u)
#define DP_ISSUE_K(t_) do { if ((t_) < nt) { _Pragma("unroll") for (int i_ = 0; i_ < 4; ++i_) kreg[i_] = *(const u32x4*)((const char*)Kp + DP_KOFF(t_, i_)); } } while (0)
#define DP_COMMIT_K(t_) do { if ((t_) < nt) { _Pragma("unroll") for (int i_ = 0; i_ < 4; ++i_) *(LAS u32x4*)(lds + ((t_) & 1) * KBYTES + (sr + 16 * i_) * KSTR + sc16 * 16) = kreg[i_]; } } while (0)
        bf16x8 qf[8]; load_q(qf, Qp, (long)row0 + qpos, hi);
        DP_ISSUE_K(0); DP_COMMIT_K(0); DP_ISSUE_K(1);
        DP_BAR();
        const int kro = (lane & 31) * KSTR + hi * 16;
        f32x16 s0, s1; bf16x8 P[4]; float m = NEG, l = 0.f;
#pragma unroll
        for (int q = 0; q < 4; ++q) P[q] = (bf16x8){0, 0, 0, 0, 0, 0, 0, 0};
        for (int tau = -1; tau < nt; ++tau) {
            asm volatile("" : "+v"(sr), "+v"(sc16));
            if (tau >= 0 && 64 * tau <= wqhi) DP_PV(tau, P);
#pragma unroll
            for (int e = 0; e < 16; ++e) { s0[e] = 0.f; s1[e] = 0.f; }
            const int t = tau + 1;
            const bool act = t < nt && 64 * t <= wqhi;
            if (act) {
                const LAS unsigned char* kb = lds + (t & 1) * KBYTES + kro;
                bf16x8 fk[2][4];
#pragma unroll
                for (int j = 0; j < 2; ++j) { fk[0][2 * j] = *(const LAS bf16x8*)(kb + j * 32); fk[0][2 * j + 1] = *(const LAS bf16x8*)(kb + 32 * KSTR + j * 32); }
                __builtin_amdgcn_sched_barrier(0);
#pragma unroll
                for (int c2 = 0; c2 < 4; ++c2) {
                    if (c2 < 3) {
#pragma unroll
                        for (int j = 0; j < 2; ++j) { fk[(c2 + 1) & 1][2 * j] = *(const LAS bf16x8*)(kb + (2 * (c2 + 1) + j) * 32); fk[(c2 + 1) & 1][2 * j + 1] = *(const LAS bf16x8*)(kb + 32 * KSTR + (2 * (c2 + 1) + j) * 32); }
                    }
#pragma unroll
                    for (int j = 0; j < 2; ++j) {
                        s0 = __builtin_amdgcn_mfma_f32_32x32x16_bf16(fk[c2 & 1][2 * j], qf[2 * c2 + j], s0, 0, 0, 0);
                        s1 = __builtin_amdgcn_mfma_f32_32x32x16_bf16(fk[c2 & 1][2 * j + 1], qf[2 * c2 + j], s1, 0, 0, 0);
                    }
                    __builtin_amdgcn_sched_barrier(0);
                }
            }
            DP_COMMIT_K(tau + 2); DP_ISSUE_K(tau + 3);
            if (act) {
                const int ks = 64 * t;
                if (ks + 63 > qlo) {
#pragma unroll
                    for (int e = 0; e < 16; ++e) { const int kp0 = ks + crow(e, hi), kp1 = kp0 + 32; s0[e] = kp0 <= qpos ? s0[e] : NEGR; s1[e] = kp1 <= qpos ? s1[e] : NEGR; }
                }
                float mxa = max3f(s0[0], s0[1], s1[0]), mxb = max3f(s0[2], s0[3], s1[1]);
                mxa = max3f(mxa, s1[2], s1[3]);
#pragma unroll
                for (int e = 4; e < 16; e += 4) { mxa = max3f(mxa, s0[e], s0[e + 1]); mxb = max3f(mxb, s0[e + 2], s0[e + 3]); mxa = max3f(mxa, s1[e], s1[e + 1]); mxb = max3f(mxb, s1[e + 2], s1[e + 3]); }
                float mx = max2f(mxa, mxb);
                mx = xhalf_max(mx);
                const float mn = max2f(m, mx * SC);
                const float a = __builtin_amdgcn_exp2f(m - mn);
                if (__any(mn > m)) {
                    l *= a; m = mn;
#pragma unroll
                    for (int b = 0; b < 4; ++b)
#pragma unroll
                        for (int e = 0; e < 16; ++e) O[b][e] *= a;
                }
                float ps = 0.f, ps1 = 0.f;
#pragma unroll
                for (int e = 0; e < 16; ++e) { s0[e] = __builtin_amdgcn_exp2f(__builtin_fmaf(s0[e], SC, -m)); s1[e] = __builtin_amdgcn_exp2f(__builtin_fmaf(s1[e], SC, -m)); ps += s0[e]; ps1 += s1[e]; }
                l += ps + ps1;
                P[0] = pack8(s0, 0); P[1] = pack8(s0, 8); P[2] = pack8(s1, 0); P[3] = pack8(s1, 8);
                LAS unsigned char* pp = pbase + (t & 1) * DP_PSLOT;
#pragma unroll
                for (int q = 0; q < 4; ++q) *(LAS bf16x8*)(pp + q * 1024) = P[q];
                *(LAS float*)(pp + 4 * 1024) = a;
            }
            DP_BAR();
        }
        l = xhalf_sum(l);
        inv_l = 1.0f / l;
        *(LAS float*)(pbase + 4 * 1024 + 4) = inv_l;
        DP_BAR();
#undef DP_KOFF
#undef DP_ISSUE_K
#undef DP_COMMIT_K
    } else {
        const int ct = tid - 256; int vr = ct >> 5, vc = ct & 31;
        u32x4 vreg[8];
#define DP_VOFF(t_, i_) (((unsigned)(row0 + 64 * (t_) + vr + 8 * (i_)) * (unsigned)NQKV + (unsigned)(vc * 8)) * 2u)
#define DP_ISSUE_V(t_) do { if ((t_) < nt) { _Pragma("unroll") for (int i_ = 0; i_ < 8; ++i_) vreg[i_] = *(const u32x4*)((const char*)Vp + DP_VOFF(t_, i_)); } } while (0)
#define DP_COMMIT_V(t_) do { if ((t_) < nt) { _Pragma("unroll") for (int i_ = 0; i_ < 8; ++i_) *(LAS u32x4*)(lds + DP_V + ((t_) & 1) * VB2 + (vr + 8 * i_) * VS2 + vc * 16) = vreg[i_]; } } while (0)
        DP_ISSUE_V(0);
        DP_BAR();
        for (int tau = -1; tau < nt; ++tau) {
            asm volatile("" : "+v"(vr), "+v"(vc));
            DP_COMMIT_V(tau + 1); DP_ISSUE_V(tau + 2);
            if (tau >= 0 && 64 * tau <= wqhi) {
                const LAS unsigned char* pp = pbase + (tau & 1) * DP_PSLOT;
                bf16x8 P[4];
#pragma unroll
                for (int q = 0; q < 4; ++q) P[q] = *(const LAS bf16x8*)(pp + q * 1024);
                const float a = *(const LAS float*)(pp + 4 * 1024);
                if (__any(a != 1.0f)) {
#pragma unroll
                    for (int b = 0; b < 4; ++b)
#pragma unroll
                        for (int e = 0; e < 16; ++e) O[b][e] *= a;
                }
                DP_PV(tau, P);
            }
            DP_BAR();
        }
        DP_BAR();
        inv_l = *(const LAS float*)(pbase + 4 * 1024 + 4);
#undef DP_VOFF
#undef DP_ISSUE_V
#undef DP_COMMIT_V
    }
    DP_BAR();
#undef DP_PV
#undef DP_BAR
}
}

#define XB_TMO      128
#define XB_XCNT(j)  (256  + 64 * (j))
#define XB_XSUB(j)  (1280 + 64 * (j))
#define XB_XGEN(j)  (2304 + 64 * (j))
#define XB_TOP      3328
#define XB_TOPGEN   3392
#define XCD_BAR_WORDS 3456
#define XB_SPIN_CAP (1u << 22)

__device__ __forceinline__ unsigned xb_ld(unsigned* p)              { return __hip_atomic_load(p, __ATOMIC_RELAXED, __HIP_MEMORY_SCOPE_AGENT); }
__device__ __forceinline__ unsigned xb_add(unsigned* p, unsigned v) { return __hip_atomic_fetch_add(p, v, __ATOMIC_RELAXED, __HIP_MEMORY_SCOPE_AGENT); }
__device__ __forceinline__ unsigned xb_xcc_id() { return (unsigned)__builtin_amdgcn_s_getreg((3 << 11) | 20) & 0xFu; }
#define XB_SPIN(cond, bar) do { unsigned _sp = 0; while (cond) { __builtin_amdgcn_s_sleep(1); \
    if ((++_sp & 255u) == 0u) { if (xb_ld(&(bar)[XB_TMO])) break; if (_sp > XB_SPIN_CAP) { atomicAdd(&(bar)[XB_TMO], 1u); break; } } } } while (0)

struct XcdBarrier {
    unsigned* bar; unsigned x;
    volatile LAS unsigned* st;
};

__device__ __forceinline__ XcdBarrier xcd_barrier_post(unsigned* bar, volatile LAS unsigned* st, const bool t0) {
    XcdBarrier b; b.bar = bar; b.x = xb_xcc_id(); b.st = st;
    if (t0) (void)xb_add(&bar[XB_XCNT(b.x)], 1u);
    return b;
}
__device__ __forceinline__ void xcd_barrier_complete(unsigned* bar, unsigned x, unsigned& nloc, unsigned& nx) {
    const unsigned G = gridDim.x * gridDim.y * gridDim.z;
    unsigned sum, cnt, mine, sp = 0u;
    for (;;) {
        sum = 0u; cnt = 0u; mine = 0u;
#pragma unroll
        for (unsigned j = 0; j < 16; ++j) { const unsigned c = xb_ld(&bar[XB_XCNT(j)]); sum += c; cnt += (c > 0u) ? 1u : 0u; mine = (j == x) ? c : mine; }
        if (sum == G) break;
        __builtin_amdgcn_s_sleep(1);
        if ((++sp & 255u) == 0u) { if (xb_ld(&bar[XB_TMO])) break; if (sp > XB_SPIN_CAP) { atomicAdd(&bar[XB_TMO], 1u); break; } }
    }
    nloc = mine > 0u ? mine : 1u; nx = cnt > 0u ? cnt : 1u;
}

__device__ __forceinline__ void xcd_barrier(const XcdBarrier& b, const bool t0) {
    asm volatile("s_waitcnt vmcnt(0)" ::: "memory");
    __syncthreads();
    if (t0) {
        unsigned* bar = b.bar;
        __builtin_amdgcn_s_waitcnt(0);
        unsigned nloc = b.st[0], nx = b.st[1];
        if (nloc == 0u) { xcd_barrier_complete(bar, b.x, nloc, nx); b.st[0] = nloc; b.st[1] = nx; }
        const unsigned old = xb_add(&bar[XB_XSUB(b.x)], 1u);
        const unsigned gen = old / nloc;
        if (old + 1u == (gen + 1u) * nloc) {
            __builtin_amdgcn_fence(__ATOMIC_RELEASE, "agent");
            asm volatile("s_waitcnt vmcnt(0)" ::: "memory");
            const unsigned og = xb_add(&bar[XB_TOP], 1u);
            const unsigned tg = og / nx;
            if (og + 1u == (tg + 1u) * nx) xb_add(&bar[XB_TOPGEN], 1u);
            else XB_SPIN(xb_ld(&bar[XB_TOPGEN]) == tg, bar);
            __builtin_amdgcn_fence(__ATOMIC_ACQUIRE, "agent");
            xb_add(&bar[XB_XGEN(b.x)], 1u);
            asm volatile("s_waitcnt vmcnt(0)" ::: "memory");
        } else {
            XB_SPIN(xb_ld(&bar[XB_XGEN(b.x)]) == gen, bar);
            __builtin_amdgcn_fence(__ATOMIC_ACQUIRE, "agent");
            asm volatile("s_waitcnt vmcnt(0)" ::: "memory");
        }
    }
    __syncthreads();
}

#define AS4 __attribute__((address_space(4)))
#define PHASE_WS() const AS4 unsigned char* ka_ = (const AS4 unsigned char*)__builtin_amdgcn_kernarg_segment_ptr(); asm volatile("" : "+s"(ka_)); unsigned char* ws = *(unsigned char* const AS4*)(ka_ + 152)
#define PIN(i) (*(const float* const AS4*)(ka_ + 8 * (i)))
#define XIN PIN(0)
#define HBUF (*(float* const AS4*)(ka_ + 144))
__global__ void __launch_bounds__(512) fwd_megakernel(Params P) {
    extern __shared__ __attribute__((aligned(16))) unsigned char lds_raw[];
    LAS unsigned char* lds = (LAS unsigned char*)lds_raw;
    cg::grid_group grid = cg::this_grid();
    grid.sync();
    const int G = gridDim.x, bx = blockIdx.x, NGW = G * 8;
    const int wave_s = __builtin_amdgcn_readfirstlane((int)threadIdx.x >> 6);
#define PHASE_IDS() PHASE_WS(); int tid; asm volatile("v_mbcnt_lo_u32_b32 %0, -1, 0\n\tv_mbcnt_hi_u32_b32 %0, -1, %0" : "=v"(tid)); tid += wave_s * 64; const int lane = tid & 63, wave = wave_s, hi = lane >> 5, gw = bx * 8 + wave; (void)hi; (void)gw; (void)lane
    volatile LAS unsigned* xst = (volatile LAS unsigned*)(lds + 152576);
    { int l_; asm volatile("v_mbcnt_lo_u32_b32 %0, -1, 0\n\tv_mbcnt_hi_u32_b32 %0, -1, %0" : "=v"(l_)); if ((l_ + wave_s * 64) < 2) xst[l_] = 0u; }
    __syncthreads();
    XcdBarrier xbar;
    { int l_; asm volatile("v_mbcnt_lo_u32_b32 %0, -1, 0\n\tv_mbcnt_hi_u32_b32 %0, -1, %0" : "=v"(l_)); PHASE_WS(); xbar = xcd_barrier_post((unsigned*)(ws + WS_CTL), xst, (l_ + wave_s * 64) == 0); }
#define XN ((bf16_t*)(ws + WS_XN))
#define BIG ((bf16_t*)(ws + WS_BIG))
#define ATT ((bf16_t*)(ws + WS_ATT))
#define PART ((bf16_t*)(ws + WS_PART))
#define LSE ((float*)(ws + WS_LSE))
#define COS ((float*)(ws + WS_ROPE))
#define SIN (COS + SEQ * 64)
#define KMEAN ((float*)(ws + WS_KMEAN))
    constexpr unsigned long long ROPE_EVEN = 0x000000FFFF00FFFFull;
    constexpr unsigned long long ROPE_ODD = 0x00000000FFFFFFFFull;

    {
        PHASE_IDS();
        LAS float* scr = (LAS float*)(lds + wave * 8448);
#ifndef NO_TRANSP
        for (int rep = 0; rep < REP_PRO; ++rep) {
        for (int l = 0; l < 2; ++l) {
            transpose_items<1>(PIN(2) + (size_t)l * DM * 2 * DFF, DM, 2 * DFF, (bf16_t*)(ws + WS_FFA_IN + l * SZ_WIN), 0, scr, gw, NGW, lane);
            transpose_items<0>(PIN(3) + (size_t)l * DFF * DM, DFF, DM, (bf16_t*)(ws + WS_FFA_OUT + l * SZ_WOUT), 0, scr, gw, NGW, lane);
            transpose_items<1>(PIN(15) + (size_t)l * DM * 2 * DFF, DM, 2 * DFF, (bf16_t*)(ws + WS_FFB_IN + l * SZ_WIN), 0, scr, gw, NGW, lane);
            transpose_items<0>(PIN(16) + (size_t)l * DFF * DM, DFF, DM, (bf16_t*)(ws + WS_FFB_OUT + l * SZ_WOUT), 0, scr, gw, NGW, lane);
        }
        transpose_items<2>(PIN(5), DM, NQKV, (bf16_t*)(ws + WS_MIX_IN), ROPE_EVEN, scr, gw, NGW, lane);
        transpose_items<2>(PIN(7), DM, NQKV, (bf16_t*)(ws + WS_MIX_IN + SZ_WMIN), ROPE_ODD, scr, gw, NGW, lane);
        transpose_items<0>(PIN(6), DM, DM, (bf16_t*)(ws + WS_MIX_OUT), 0, scr, gw, NGW, lane);
        transpose_items<0>(PIN(8), DM, DM, (bf16_t*)(ws + WS_MIX_OUT + SZ_WMOUT), 0, scr, gw, NGW, lane);
        }
#endif
#ifndef NO_ROPETAB
        for (int idx = bx * 512 + tid; idx < SEQ * 64; idx += G * 512) {
            const int pos = idx >> 6, j = idx & 63;
            const float inv = (float)pow(10000.0, -(double)j / 64.0);
            const float ang = (float)pos * inv;
            const double a = (double)ang, n = rint(a * 0.15915494309189535);
            const double r = (a - n * 6.283185307179586) - n * 2.4492935982947064e-16;
            COS[idx] = (float)cos(r); SIN[idx] = (float)sin(r);
        }
#endif
        norm_phase<false>(XIN, PIN(1), XN, gw, NGW, lane);
    }
    GSYNC();

    for (int layer = 0; layer < 2; ++layer) {
        {
            PHASE_WS();
            pg8::Gemm g{XN, (const bf16_t*)(ws + WS_FFA_IN + layer * SZ_WIN), MTOK, 2 * DFF, DM}; pg8::StaticOrder S; { int g_ = G, b_ = bx; asm volatile("" : "+s"(g_), "+s"(b_)); S.init(MTOK, 2 * DFF, g_, b_); }
            pg8::EpiSwiGLU E{BIG, DFF};
#ifndef NO_EPISWIGLU
            for (int rep = 0; rep < REP_SWI; ++rep) pg8::gemm_phase<pg8::EpiSwiGLU, pg8::StaticOrder, true, true>(lds, g, S, E, wave_s);
#endif
        }
        GSYNC();
        {
            PHASE_WS();
            pg8::Gemm g{BIG, (const bf16_t*)(ws + WS_FFA_OUT + layer * SZ_WOUT), MTOK, DM, DFF}; pg8::StaticOrder S; { int g_ = G, b_ = bx; asm volatile("" : "+s"(g_), "+s"(b_)); S.init(MTOK, DM, g_, b_); }
            pg8::EpiResid E{layer == 0 ? XIN : HBUF, HBUF, DM, 0.5f};
#ifndef NO_EPIRESID
            for (int rep = 1; rep < REP_RES; ++rep) { pg8::EpiResid E0 = E; E0.scale = 0.f; pg8::gemm_phase<pg8::EpiResid, pg8::StaticOrder, true, true>(lds, g, S, E0, wave_s); }
            pg8::gemm_phase<pg8::EpiResid, pg8::StaticOrder, true, true>(lds, g, S, E, wave_s);
#endif
        }
        GSYNC();
        { PHASE_IDS(); for (int rep = 0; rep < REP_NORM; ++rep) norm_phase<false>(HBUF, PIN(4) + layer * DM, XN, gw, NGW, lane); }
        GSYNC();
        {
            PHASE_WS();
            pg8::Gemm g{XN, (const bf16_t*)(ws + WS_MIX_IN + layer * SZ_WMIN), MTOK, NQKV, DM}; pg8::StaticOrder S; { int g_ = G, b_ = bx; asm volatile("" : "+s"(g_), "+s"(b_)); S.init(MTOK, NQKV, g_, b_); }
            pg8::EpiQKV E{BIG, NQKV, COS, SIN, layer == 0 ? ROPE_EVEN : ROPE_ODD};
#ifndef NO_EPIQKV
            for (int rep = 0; rep < REP_QKV; ++rep) pg8::gemm_phase<pg8::EpiQKV, pg8::StaticOrder, true, true>(lds, g, S, E, wave_s);
#endif
        }
        GSYNC();
        if (layer == 0) {
            PHASE_IDS();
            for (int rep = 0; rep < REP_DIL; ++rep) {
            for (int it = bx; it < 512; it += G) {
                const int b = it >> 8, h = (it >> 5) & 7, blk = it & 31, c = tid & 127, rg = tid >> 7;
                const bf16_t* kp = BIG + (size_t)(b * SEQ + blk * 256 + rg * 64) * NQKV + 4096 + h * 128 + c;
                float s = 0.f;
                for (int r = 0; r < 64; ++r) s += bf2f(kp[(size_t)r * NQKV]);
                LAS float* red = (LAS float*)lds;
                red[rg * 128 + c] = s; __syncthreads();
                if (tid < 128) KMEAN[(size_t)it * 128 + tid] = (red[tid] + red[128 + tid] + red[256 + tid] + red[384 + tid]) * (1.0f / 256.0f);
                __syncthreads();
            }
#ifndef NO_DIL
            for (int un = bx; un < 1536; un += G) {
                const int u = un & 31, br = (un >> 5) % 3, bh = un / 96, b = bh >> 3, h = bh & 7;
                const int dl = br == 0 ? 1 : (br == 1 ? 4 : 16);
                const int upr = 32 / dl, res = u / upr, ub = u % upr;
                const long row0 = (long)b * SEQ + res;
                const int qlo = 256 * ub + 32 * wave, qpos = qlo + (lane & 31);
                bf16x8 qf[8]; att::load_q(qf, BIG + h * 128, row0 + (long)qpos * dl, hi);
                f32x16 O[4]; float m, l; att::zero_state(O, m, l);
                att::TSDil ts{256 * ub - 128, qlo, qpos};
                att::flash_pass(lds, BIG + 1024 + h * 128, BIG + 2048 + h * 128, row0, dl, qf, ts, O, m, l, tid);
                l = att::xhalf_sum(l);
                const long grow = row0 + (long)qpos * dl;
                att::store_o(O, 1.0f / l, PART + ((size_t)br * MTOK + grow) * 1024 + h * 128, hi);
                if (hi == 0) LSE[((size_t)br * MTOK + grow) * 8 + h] = m + log2f(l);
            }
#endif
            }
        } else {
            PHASE_IDS();
#ifndef NO_DIFF
            const float lam_init = 0.35550906759096927f;
            float d1 = 0.f, d2 = 0.f;
            for (int i = 0; i < 128; ++i) { d1 += PIN(9)[i] * PIN(10)[i]; d2 += PIN(11)[i] * PIN(12)[i]; }
            const float lam = __uint_as_float(__builtin_amdgcn_readfirstlane(__float_as_uint(expf(d1) - expf(d2) + lam_init)));
            float* park = (float*)PART + (size_t)bx * 64 * 512;
            LAS float* ssx = (LAS float*)(lds + att::DP_END);
            for (int rep = 0; rep < REP_DIFF; ++rep)
            for (int un = bx; un < 1024; un += G) {
                const int j4 = un >> 8, c8 = un & 255, bh = c8 >> 4, x16 = c8 & 15, b = bh >> 3, h = bh & 7;
                const int qb = j4 == 0 ? 63 - x16 : (j4 == 1 ? 32 + x16 : (j4 == 2 ? 31 - x16 : x16));
                const int row0 = b * SEQ;
                f32x16 O[4]; float inv_l; float ss = 0.f;
#pragma unroll 1
                for (int pr = 0; pr < 2; ++pr) {
                    att::diff_pass(lds, BIG + 2048 + h * 256 + pr * 128, BIG + 4096 + h * 256, BIG + h * 256 + pr * 128, row0, qb, O, inv_l, tid);
                    int tl = tid; asm volatile("" : "+v"(tl));
                    f32x4* pk = (f32x4*)(park + (size_t)tl * 64);
                    if (pr == 0) {
#pragma unroll
                        for (int bb = 0; bb < 4; ++bb)
#pragma unroll
                            for (int g4 = 0; g4 < 4; ++g4) pk[bb * 4 + g4] = (f32x4){O[bb][4 * g4], O[bb][4 * g4 + 1], O[bb][4 * g4 + 2], O[bb][4 * g4 + 3]} * inv_l;
                    } else {
#pragma unroll
                        for (int bb = 0; bb < 4; ++bb)
#pragma unroll
                            for (int g4 = 0; g4 < 4; ++g4) { const f32x4 pv = pk[bb * 4 + g4];
#pragma unroll
                                for (int i = 0; i < 4; ++i) { const float v = pv[i] - lam * (O[bb][4 * g4 + i] * inv_l); O[bb][4 * g4 + i] = v; ss += v * v; } }
                    }
                }
                ss = att::xhalf_sum(ss);
                ssx[tid] = ss;
                __syncthreads();
                ss += ssx[tid ^ 256];
                __syncthreads();
                const float rs = (1.0f - lam_init) / sqrtf(ss * (1.0f / 256.0f) + 1e-5f);
                const int half = tid >> 8;
                const float* sg = PIN(13) + half * 128;
#pragma unroll
                for (int bb = 0; bb < 4; ++bb)
#pragma unroll
                    for (int g4 = 0; g4 < 4; ++g4) {
                        const f32x4 ga = *(const f32x4*)(sg + 32 * bb + 8 * g4 + 4 * hi);
#pragma unroll
                        for (int i = 0; i < 4; ++i) O[bb][4 * g4 + i] *= ga[i];
                    }
                att::store_o(O, rs, ATT + (size_t)(row0 + 128 * qb + 32 * (wave & 3) + (lane & 31)) * DM + h * 256 + half * 128, hi);
            }
#endif
        }
        GSYNC();
        if (layer == 0) {
            PHASE_IDS();
            for (int rep = 0; rep < REP_MOBA; ++rep) {
            for (int idx = bx * 512 + tid; idx < MTOK * 128; idx += G * 512) {
                const int row = idx >> 7, h = (idx >> 4) & 7, ch = idx & 15;
                float L[3]; u32x4 pv[3];
#pragma unroll
                for (int br = 0; br < 3; ++br) { L[br] = LSE[((size_t)br * MTOK + row) * 8 + h]; pv[br] = *(const u32x4*)(PART + ((size_t)br * MTOK + row) * 1024 + h * 128 + ch * 8); }
                const float mx = fmaxf(L[0], fmaxf(L[1], L[2]));
                float w[3]; float sw = 0.f;
#pragma unroll
                for (int br = 0; br < 3; ++br) { w[br] = __builtin_amdgcn_exp2f(L[br] - mx); sw += w[br]; }
                const float isw = 1.0f / sw;
                float o[8];
#pragma unroll
                for (int i = 0; i < 8; ++i) o[i] = 0.f;
#pragma unroll
                for (int br = 0; br < 3; ++br) { const float wb = w[br] * isw;
#pragma unroll
                    for (int i = 0; i < 4; ++i) { const unsigned wd = pv[br][i]; o[2 * i] += wb * bf2f((unsigned short)(wd & 0xffffu)); o[2 * i + 1] += wb * bf2f((unsigned short)(wd >> 16)); } }
                u32x4 r; r.x = pk2(o[0], o[1]); r.y = pk2(o[2], o[3]); r.z = pk2(o[4], o[5]); r.w = pk2(o[6], o[7]);
                *(u32x4*)(ATT + (size_t)row * DM + h * 128 + ch * 8) = r;
            }
#ifndef NO_MOBA
            LAS float* kmL = (LAS float*)(lds + 77824);
            LAS unsigned* selL = (LAS unsigned*)(lds + 94208);
            LAS unsigned* wmL = (LAS unsigned*)(lds + 95232);
            LAS int* listL = (LAS int*)(lds + 95296);
            for (int un = bx; un < 512; un += G) {
                const int sel = un & 255, bh = sel >> 4, qb = (un < 256) ? 31 - (sel & 15) : (sel & 15), b = bh >> 3, h = bh & 7;
                const long row0 = (long)b * SEQ;
                for (int i = tid; i < qb * 128; i += 512) kmL[i] = KMEAN[(size_t)(bh * 32) * 128 + i];
                __syncthreads();
                {
                    const int q = tid >> 1, part = tid & 1;
                    const bf16_t* qp = BIG + (size_t)(row0 + qb * 256 + q) * NQKV + 3072 + h * 128 + 64 * part;
                    float qv[64];
#pragma unroll
                    for (int c = 0; c < 8; ++c) { const u32x4 w = *(const u32x4*)(qp + 8 * c);
#pragma unroll
                        for (int i = 0; i < 4; ++i) { qv[8 * c + 2 * i] = bf2f((unsigned short)(w[i] & 0xffffu)); qv[8 * c + 2 * i + 1] = bf2f((unsigned short)(w[i] >> 16)); } }
                    float v0 = -3e38f, v1 = -3e38f, v2 = -3e38f; int i0 = -1, i1 = -1, i2 = -1;
                    for (int j = 0; j < qb; ++j) {
                        const LAS float* km = kmL + j * 128 + 64 * part; float d = 0.f;
#pragma unroll
                        for (int i = 0; i < 64; ++i) d += qv[i] * km[i];
                        d += shfl_xor_f(d, 1, lane);
                        if (d > v0) { v2 = v1; i2 = i1; v1 = v0; i1 = i0; v0 = d; i0 = j; }
                        else if (d > v1) { v2 = v1; i2 = i1; v1 = d; i1 = j; }
                        else if (d > v2) { v2 = d; i2 = j; }
                    }
                    unsigned mk = 0u; if (i0 >= 0) mk |= 1u << i0; if (i1 >= 0) mk |= 1u << i1; if (i2 >= 0) mk |= 1u << i2;
                    if (part == 0) selL[q] = mk;
                }
                __syncthreads();
                const unsigned lmask = selL[32 * wave + (lane & 31)];
                unsigned wm = lmask, am = lmask;
#pragma unroll
                for (int o = 1; o < 64; o <<= 1) { wm |= (unsigned)shfl_xor_i((int)wm, o, lane); am &= (unsigned)shfl_xor_i((int)am, o, lane); }
                if (lane == 0) wmL[wave] = wm;
                __syncthreads();
                if (tid == 0) {
                    unsigned U = 0u; for (int w = 0; w < 8; ++w) U |= wmL[w];
                    int n = 0;
                    for (int j = 0; j < qb; ++j) if ((U >> j) & 1u) { for (int i = 0; i < 4; ++i) listL[n++] = 256 * j + 64 * i; }
                    for (int i = 0; i < 4; ++i) listL[n++] = 256 * qb + 64 * i;
                    listL[130] = n;
                }
                __syncthreads();
                const int qlo = 256 * qb + 32 * wave, qpos = qlo + (lane & 31);
                bf16x8 qf[8]; att::load_q(qf, BIG + 3072 + h * 128, row0 + qpos, hi);
                f32x16 O[4]; float m, l; att::zero_state(O, m, l);
                att::TSMoba ts{listL, listL[130], qb, qpos, qlo + 31, wm, lmask, am};
                att::flash_pass(lds, BIG + 4096 + h * 128, BIG + 5120 + h * 128, row0, 1, qf, ts, O, m, l, tid);
                l = att::xhalf_sum(l);
                att::store_o(O, 1.0f / l, ATT + (size_t)(row0 + qpos) * DM + 1024 + h * 128, hi);
                __syncthreads();
            }
#endif
            }
            GSYNC();
        }
        {
            PHASE_WS();
            pg8::Gemm g{ATT, (const bf16_t*)(ws + WS_MIX_OUT + layer * SZ_WMOUT), MTOK, DM, DM}; pg8::StaticOrder S; { int g_ = G, b_ = bx; asm volatile("" : "+s"(g_), "+s"(b_)); S.init(MTOK, DM, g_, b_); }
            pg8::EpiResid E{HBUF, HBUF, DM, 1.0f};
#ifndef NO_EPIRESID
            for (int rep = 1; rep < REP_RES; ++rep) { pg8::EpiResid E0 = E; E0.scale = 0.f; pg8::gemm_phase<pg8::EpiResid, pg8::StaticOrder, true, true>(lds, g, S, E0, wave_s); }
            pg8::gemm_phase<pg8::EpiResid, pg8::StaticOrder, true, true>(lds, g, S, E, wave_s);
#endif
        }
        GSYNC();
        { PHASE_IDS(); for (int rep = 0; rep < REP_NORM; ++rep) norm_phase<false>(HBUF, PIN(14) + layer * DM, XN, gw, NGW, lane); }
        GSYNC();
        {
            PHASE_WS();
            pg8::Gemm g{XN, (const bf16_t*)(ws + WS_FFB_IN + layer * SZ_WIN), MTOK, 2 * DFF, DM}; pg8::StaticOrder S; { int g_ = G, b_ = bx; asm volatile("" : "+s"(g_), "+s"(b_)); S.init(MTOK, 2 * DFF, g_, b_); }
            pg8::EpiSwiGLU E{BIG, DFF};
#ifndef NO_EPISWIGLU
            for (int rep = 0; rep < REP_SWI; ++rep) pg8::gemm_phase<pg8::EpiSwiGLU, pg8::StaticOrder, true, true>(lds, g, S, E, wave_s);
#endif
        }
        GSYNC();
        {
            PHASE_WS();
            pg8::Gemm g{BIG, (const bf16_t*)(ws + WS_FFB_OUT + layer * SZ_WOUT), MTOK, DM, DFF}; pg8::StaticOrder S; { int g_ = G, b_ = bx; asm volatile("" : "+s"(g_), "+s"(b_)); S.init(MTOK, DM, g_, b_); }
            pg8::EpiResid E{HBUF, HBUF, DM, 0.5f};
#ifndef NO_EPIRESID
            for (int rep = 1; rep < REP_RES; ++rep) { pg8::EpiResid E0 = E; E0.scale = 0.f; pg8::gemm_phase<pg8::EpiResid, pg8::StaticOrder, true, true>(lds, g, S, E0, wave_s); }
            pg8::gemm_phase<pg8::EpiResid, pg8::StaticOrder, true, true>(lds, g, S, E, wave_s);
#endif
        }
        GSYNC();
        if (layer == 0) { { PHASE_IDS(); norm_phase<false>(HBUF, PIN(1) + DM, XN, gw, NGW, lane); } GSYNC(); }
        else { PHASE_IDS(); norm_phase<true>(HBUF, PIN(17), HBUF, gw, NGW, lane); }
    }
}

extern "C" void kernel_launch(void* const* d_in, const int* in_sizes, int n_in, void* d_out, int out_size, void* d_ws, size_t ws_size, hipStream_t stream) {
    static int grid_blocks = 0;
    if (grid_blocks == 0) {
        if (n_in != 18 || ws_size < WS_END) { fprintf(stderr, "kernel_launch: need 18 inputs and %zu bytes of workspace; got %d, %zu\n", (size_t)WS_END, n_in, ws_size); grid_blocks = -1; return; }
        int dev = 0, cus = 0, per_cu = 0;
        hipGetDevice(&dev);
        hipDeviceGetAttribute(&cus, hipDeviceAttributeMultiprocessorCount, dev);
        hipFuncSetAttribute((const void*)fwd_megakernel, hipFuncAttributeMaxDynamicSharedMemorySize, LDS_BYTES);
        hipOccupancyMaxActiveBlocksPerMultiprocessor(&per_cu, (const void*)fwd_megakernel, 512, LDS_BYTES);
        if (per_cu < 1) { fprintf(stderr, "kernel_launch: occupancy query says %d blocks per CU\n", per_cu); per_cu = 1; }
        (void)hipGetLastError();
        grid_blocks = cus * per_cu;
    }
    if (grid_blocks < 0) return;
    if (hipMemsetAsync((char*)d_ws + WS_CTL, 0, CTL_BYTES, stream) != hipSuccess) { fprintf(stderr, "kernel_launch: hipMemsetAsync failed\n"); return; }
    Params p{};
    for (int i = 0; i < 18; ++i) p.in[i] = (const float*)d_in[i];
    p.out = (float*)d_out; p.ws = (unsigned char*)d_ws;
    void* args[] = {&p};
    hipError_t e = hipLaunchCooperativeKernel((const void*)fwd_megakernel, dim3(grid_blocks), dim3(512), args, LDS_BYTES, stream);
    if (e != hipSuccess) fprintf(stderr, "cooperative launch failed: %s (grid %d)\n", hipGetErrorString(e), grid_blocks);
}
```

```cpp
#include <hip/hip_runtime.h>
#include <hip/hip_cooperative_groups.h>
#include <cstdio>
#include <cstdint>
namespace cg = cooperative_groups;
namespace pg8 {
#define PG8_LAS __attribute__((address_space(3)))
typedef unsigned short bf16_t;
typedef short bf16x8 __attribute__((ext_vector_type(8)));
typedef float f32x4 __attribute__((ext_vector_type(4)));
typedef unsigned u32x4 __attribute__((ext_vector_type(4)));
constexpr int BM = 256, BK = 64, HALF = 128, HTB = HALF * BK * 2  , STAGE_BYTES = 8 * HTB, NXCD = 8, WGM = 8;

__host__ __device__ __forceinline__ int lds_byte(int r, int c) { const int st = (r >> 4) * 2 + (c >> 5), rr = r & 15, cc = c & 31, ob = rr * 64 + cc * 2; return st * 1024 + (ob ^ (((ob >> 9) & 1) << 5)); }
__host__ __device__ __forceinline__ void stage_rc(int b, int& R, int& C) { const int st = b / 1024, sb = b % 1024, swz = sb ^ (((sb >> 9) & 1) << 5); R = (st >> 1) * 16 + swz / 64; C = (st & 1) * 32 + (swz % 64) / 2; }
__host__ __device__ __forceinline__ int perm32(int rho) { const int n = rho >> 4, i = rho & 15; return 8 * (i >> 2) + 4 * n + (i & 3); }

struct Unit { int pm, pn; };
struct Gemm { const bf16_t* A; const bf16_t* Bt; int M, N, K; };

struct StaticOrder {
    int nM, nN, nwg, G, c;
    __host__ __device__ void init(int M, int N, int G_, int c_) { nM = M / BM; nN = N / BM; nwg = nM * nN; G = G_; c = c_; }
    __host__ __device__ bool next(int i, Unit& u) const {
        const long L = (long)i * G + c; if (L >= nwg) return false;
        int wgid = (int)L; { const int q = nwg / NXCD, r = nwg % NXCD, xcd = wgid % NXCD, off = wgid / NXCD; wgid = (xcd < r ? xcd * (q + 1) : r * (q + 1) + (xcd - r) * q) + off; }
        const int nig = WGM * nN, gid = wgid / nig, fm = gid * WGM, gsz = (nM - fm) < WGM ? (nM - fm) : WGM;
        u.pm = fm + ((wgid % nig) % gsz); u.pn = (wgid % nig) / gsz; return true;
    }
    __device__ __forceinline__ void a_ready(const Unit&) const {}
    __device__ __forceinline__ void done(const Unit&) const {}
};

__device__ __forceinline__ unsigned cvt_pk_bf16(float lo, float hi) { unsigned r; asm volatile("v_cvt_pk_bf16_f32 %0, %1, %2" : "=v"(r) : "v"(lo), "v"(hi)); return r; }
typedef float f32x2 __attribute__((ext_vector_type(2)));
struct EpiSwiGLU {
    static constexpr bool PERM = true, AFTER_DRAIN = false;
    bf16_t* O; int ldc;
    __device__ __forceinline__ void operator()(const f32x4 (&acc)[2][2][4][2], const Unit& u, int wr, int wc, int fr, int fq) const {
        const int row0 = u.pm * BM + wr * 64 + fr, col0 = u.pn * HALF + wc * 32 + 8 * fq;
#pragma unroll
        for (int ai = 0; ai < 2; ++ai)
#pragma unroll
            for (int m = 0; m < 4; ++m) {
                bf16_t* rowp = O + (size_t)(row0 + ai * HALF + m * 16) * ldc + col0;
                float h[8];
#pragma unroll
                for (int n = 0; n < 2; ++n)
#pragma unroll
                    for (int e = 0; e < 4; ++e) { const float g = acc[ai][0][m][n][e], up = acc[ai][1][m][n][e];
                        const float sg = __builtin_amdgcn_rcpf(1.0f + __builtin_amdgcn_exp2f(-1.4426950408889634f * g)); h[n * 4 + e] = g * sg * up; }
                u32x4 w; w.x = cvt_pk_bf16(h[0], h[1]); w.y = cvt_pk_bf16(h[2], h[3]); w.z = cvt_pk_bf16(h[4], h[5]); w.w = cvt_pk_bf16(h[6], h[7]);
                *(u32x4*)rowp = w;
            }
    }
};
struct EpiResid {
    static constexpr bool PERM = true, AFTER_DRAIN = false;
    const float* base; float* out; int ldc; float scale;
    __device__ __forceinline__ void operator()(const f32x4 (&acc)[2][2][4][2], const Unit& u, int wr, int wc, int fr, int fq) const {
        const int row0 = u.pm * BM + wr * 64 + fr, col0 = u.pn * BM + wc * 32 + 8 * fq;
#pragma unroll
        for (int ai = 0; ai < 2; ++ai)
#pragma unroll
            for (int m = 0; m < 4; ++m)
#pragma unroll
                for (int bj = 0; bj < 2; ++bj) {
                    const size_t p = (size_t)(row0 + ai * HALF + m * 16) * ldc + col0 + bj * HALF;
                    const f32x4 b0 = *(const f32x4*)(base + p), b1 = *(const f32x4*)(base + p + 4);
                    *(f32x4*)(out + p) = b0 + acc[ai][bj][m][0] * scale; *(f32x4*)(out + p + 4) = b1 + acc[ai][bj][m][1] * scale;
                }
    }
};
struct EpiQKV {
    static constexpr bool PERM = true, AFTER_DRAIN = false;
    bf16_t* O; int ldc; const float* cosT; const float* sinT; unsigned long long ropemask;
    __device__ __forceinline__ void operator()(const f32x4 (&acc)[2][2][4][2], const Unit& u, int wr, int wc, int fr, int fq) const {
        const int row0 = u.pm * BM + wr * 64 + fr, col0 = u.pn * BM + wc * 32 + 8 * fq, j0 = 16 * wc + 4 * fq;
#pragma unroll
        for (int ai = 0; ai < 2; ++ai)
#pragma unroll
            for (int m = 0; m < 4; ++m) {
                const int row = row0 + ai * HALF + m * 16, pos = row & 8191;
                const f32x4 cs = *(const f32x4*)(cosT + pos * 64 + j0), sn = *(const f32x4*)(sinT + pos * 64 + j0);
#pragma unroll
                for (int bj = 0; bj < 2; ++bj) {
                    const bool roped = (ropemask >> (u.pn * 2 + bj)) & 1ull;
                    f32x4 v0 = acc[ai][bj][m][0], v1 = acc[ai][bj][m][1];
                    if (roped) {
                        const f32x4 a = v0, b = v1;
                        v0[0] = a[0] * cs[0] - a[1] * sn[0]; v0[1] = a[1] * cs[0] + a[0] * sn[0];
                        v0[2] = a[2] * cs[1] - a[3] * sn[1]; v0[3] = a[3] * cs[1] + a[2] * sn[1];
                        v1[0] = b[0] * cs[2] - b[1] * sn[2]; v1[1] = b[1] * cs[2] + b[0] * sn[2];
                        v1[2] = b[2] * cs[3] - b[3] * sn[3]; v1[3] = b[3] * cs[3] + b[2] * sn[3];
                    }
                    u32x4 w; w.x = cvt_pk_bf16(v0[0], v0[1]); w.y = cvt_pk_bf16(v0[2], v0[3]); w.z = cvt_pk_bf16(v1[0], v1[1]); w.w = cvt_pk_bf16(v1[2], v1[3]);
                    *(u32x4*)(O + (size_t)row * ldc + col0 + bj * HALF) = w;
                }
            }
    }
};
template <class Epi, class Sched, bool ALIGN_EPI = false, bool SP2 = false>
__device__ __forceinline__ void gemm_phase(PG8_LAS unsigned char* lds, const Gemm g, const Sched& S, const Epi& E, const int wave_s  ) {
    int tid_; asm volatile("v_mbcnt_lo_u32_b32 %0, -1, 0\n\tv_mbcnt_hi_u32_b32 %0, -1, %0" : "=v"(tid_)); tid_ += wave_s * 64;
    const int tid = tid_, wid = __builtin_amdgcn_readfirstlane(tid >> 6), lane = tid & 63, wr = wid >> 2, wc = wid & 3, fr = lane & 15, fq = lane >> 4;
    const int K = g.K, nt = K / BK;
    unsigned voffA[2], voffB[2];
#pragma unroll
    for (int i = 0; i < 2; ++i) { int R, C; stage_rc(tid * 16 + i * 8192, R, C); const int Rb = Epi::PERM ? ((R & ~31) + perm32(R & 31)) : R;
        voffA[i] = (unsigned)(R * K + C) * 2u; voffB[i] = (unsigned)(Rb * K + C) * 2u; }
    const size_t kstep = (size_t)(BK * 2);
    const size_t hstep = (size_t)HALF * K * 2;
    const size_t tstep = 2 * hstep;
    const unsigned ldsw = (unsigned)wid * 1024u;
    const int aoff = lds_byte(wr * 64 + fr, fq * 8), boff = lds_byte(wc * 32 + fr, fq * 8);
#define PG8_SA(b, h) (((b) * 2 + (h)) * HTB)
#define PG8_SB(b, h) ((4 + (b) * 2 + (h)) * HTB)
#define PG8_STAGE(bufoff, gbase, voff) do { _Pragma("unroll") for (int _i = 0; _i < 2; ++_i) \
        __builtin_amdgcn_global_load_lds((const unsigned*)((const char*)(gbase) + (voff)[_i]), (PG8_LAS unsigned*)(lds + (bufoff) + ldsw + _i * 8192), 16, 0, 0); } while (0)
#define PG8_LDA(dst, b, h) do { _Pragma("unroll") for (int m = 0; m < 4; ++m) _Pragma("unroll") for (int k = 0; k < 2; ++k) dst[m][k] = *(const PG8_LAS bf16x8*)(lds + PG8_SA(b, h) + aoff + m * 2048 + k * 1024); } while (0)
#define PG8_LDB(dst, b, h) do { _Pragma("unroll") for (int n = 0; n < 2; ++n) _Pragma("unroll") for (int k = 0; k < 2; ++k) dst[n][k] = *(const PG8_LAS bf16x8*)(lds + PG8_SB(b, h) + boff + n * 2048 + k * 1024); } while (0)
#define PG8_MMA(ai, bj, At, Bt) do { __builtin_amdgcn_s_setprio(1); _Pragma("unroll") for (int m = 0; m < 4; ++m) _Pragma("unroll") for (int n = 0; n < 2; ++n) _Pragma("unroll") for (int k = 0; k < 2; ++k) \
        acc[ai][bj][m][n] = __builtin_amdgcn_mfma_f32_16x16x32_bf16(Bt[n][k], At[m][k], acc[ai][bj][m][n], 0, 0, 0); __builtin_amdgcn_s_setprio(0); } while (0)
#define PG8_WAIT_V(n) asm volatile("s_waitcnt vmcnt(" #n ")" ::: "memory")
#define PG8_WAIT_L(n) asm volatile("s_waitcnt lgkmcnt(" #n ")" ::: "memory")
#define PG8_BAR __builtin_amdgcn_s_barrier()
#define PG8_SCHED __builtin_amdgcn_sched_barrier(0)
    Unit cur, nxt; int ui = 0;
    if (!S.next(0, cur)) return;
    f32x4 acc[2][2][4][2];
#pragma unroll
    for (int a = 0; a < 2; ++a)
#pragma unroll
        for (int b = 0; b < 2; ++b)
#pragma unroll
            for (int m = 0; m < 4; ++m)
#pragma unroll
                for (int n = 0; n < 2; ++n) acc[a][b][m][n] = (f32x4){0.f, 0.f, 0.f, 0.f};
    bf16x8 At[4][2], B0[2][2], B1[2][2];
    const char* cA = (const char*)g.A + (size_t)cur.pm * tstep; const char* cB = (const char*)g.Bt + (size_t)cur.pn * tstep;
    S.a_ready(cur);
    if constexpr (SP2) {
        PG8_STAGE(PG8_SB(0, 0), cB, voffB); PG8_STAGE(PG8_SB(0, 1), cB + hstep, voffB); PG8_STAGE(PG8_SA(0, 0), cA, voffA); PG8_STAGE(PG8_SA(0, 1), cA + hstep, voffA);
        if (wr == 1) PG8_BAR;
        PG8_WAIT_V(2); PG8_BAR;
        PG8_STAGE(PG8_SB(1, 0), cB + kstep, voffB); PG8_STAGE(PG8_SA(1, 0), cA + kstep, voffA); PG8_STAGE(PG8_SB(1, 1), cB + hstep + kstep, voffB);
        PG8_WAIT_V(6); PG8_BAR;
    } else {
        PG8_STAGE(PG8_SB(0, 0), cB, voffB); PG8_STAGE(PG8_SA(0, 0), cA, voffA); PG8_STAGE(PG8_SB(0, 1), cB + hstep, voffB); PG8_STAGE(PG8_SA(0, 1), cA + hstep, voffA);
        if (wr == 1) PG8_BAR;
        PG8_WAIT_V(4); PG8_BAR;
        PG8_STAGE(PG8_SB(1, 0), cB + kstep, voffB); PG8_STAGE(PG8_SA(1, 0), cA + kstep, voffA); PG8_STAGE(PG8_SB(1, 1), cB + hstep + kstep, voffB);
        PG8_WAIT_V(6); PG8_BAR;
    }
    for (;;) {
        const bool has_next = S.next(ui + 1, nxt);
        const char* nA = has_next ? (const char*)g.A + (size_t)nxt.pm * tstep : cA; const char* nB = has_next ? (const char*)g.Bt + (size_t)nxt.pn * tstep : cB;
        for (int t = 0; t < nt; t += 2) {
            const bool last = (t == nt - 2);
            const char* a1 = cA + (size_t)(t + 1) * kstep;
            const char* a2 = last ? nA : cA + (size_t)(t + 2) * kstep; const char* b2 = last ? nB : cB + (size_t)(t + 2) * kstep;
            const char* a3 = a2 + kstep; const char* b3 = b2 + kstep;
            if (last && has_next) S.a_ready(nxt);
            if constexpr (SP2) {
            PG8_LDB(B0, 0, 0); PG8_LDB(B1, 0, 1); PG8_SCHED; PG8_LDA(At, 0, 0); PG8_STAGE(PG8_SA(1, 1), a1 + hstep, voffA);
            PG8_WAIT_V(8); PG8_WAIT_L(0); PG8_BAR; PG8_MMA(0, 0, At, B0); PG8_MMA(0, 1, At, B1); PG8_BAR; PG8_SCHED;
            PG8_LDA(At, 0, 1); PG8_STAGE(PG8_SB(0, 0), b2, voffB); PG8_STAGE(PG8_SB(0, 1), b2 + hstep, voffB); PG8_STAGE(PG8_SA(0, 0), a2, voffA);
            PG8_WAIT_V(8); PG8_WAIT_L(0); PG8_BAR; PG8_MMA(1, 0, At, B0); PG8_MMA(1, 1, At, B1); PG8_BAR; PG8_SCHED;
            PG8_LDB(B0, 1, 0); PG8_LDB(B1, 1, 1); PG8_SCHED; PG8_LDA(At, 1, 0); PG8_STAGE(PG8_SA(0, 1), a2 + hstep, voffA);
            PG8_WAIT_V(8); PG8_WAIT_L(0); PG8_BAR; PG8_MMA(0, 0, At, B0); PG8_MMA(0, 1, At, B1); PG8_BAR; PG8_SCHED;
            PG8_LDA(At, 1, 1); PG8_STAGE(PG8_SB(1, 0), b3, voffB); PG8_STAGE(PG8_SB(1, 1), b3 + hstep, voffB); PG8_STAGE(PG8_SA(1, 0), a3, voffA);
            PG8_WAIT_V(8); PG8_WAIT_L(0); PG8_BAR; PG8_MMA(1, 0, At, B0); PG8_MMA(1, 1, At, B1); PG8_BAR; PG8_SCHED;
            } else {
            PG8_LDB(B0, 0, 0); PG8_SCHED; PG8_LDA(At, 0, 0); PG8_STAGE(PG8_SA(1, 1), a1 + hstep, voffA);
            PG8_WAIT_L(8); PG8_BAR; PG8_WAIT_L(0); PG8_MMA(0, 0, At, B0); PG8_BAR; PG8_SCHED;
            PG8_LDB(B1, 0, 1); PG8_STAGE(PG8_SB(0, 0), b2, voffB);
            PG8_BAR; PG8_WAIT_L(0); PG8_MMA(0, 1, At, B1); PG8_BAR;
            PG8_LDA(At, 0, 1); PG8_STAGE(PG8_SA(0, 0), a2, voffA);
            PG8_BAR; PG8_WAIT_L(0); PG8_MMA(1, 0, At, B0); PG8_BAR; PG8_SCHED;
            PG8_STAGE(PG8_SB(0, 1), b2 + hstep, voffB);
            PG8_WAIT_V(6); PG8_BAR; PG8_MMA(1, 1, At, B1); PG8_BAR;
            PG8_LDB(B0, 1, 0); PG8_SCHED; PG8_LDA(At, 1, 0); PG8_STAGE(PG8_SA(0, 1), a2 + hstep, voffA);
            PG8_WAIT_L(8); PG8_BAR; PG8_WAIT_L(0); PG8_MMA(0, 0, At, B0); PG8_BAR; PG8_SCHED;
            PG8_LDB(B1, 1, 1); PG8_STAGE(PG8_SB(1, 0), b3, voffB);
            PG8_BAR; PG8_WAIT_L(0); PG8_MMA(0, 1, At, B1); PG8_BAR;
            PG8_LDA(At, 1, 1); PG8_STAGE(PG8_SA(1, 0), a3, voffA);
            PG8_BAR; PG8_WAIT_L(0); PG8_MMA(1, 0, At, B0); PG8_BAR; PG8_SCHED;
            PG8_STAGE(PG8_SB(1, 1), b3 + hstep, voffB);
            PG8_WAIT_V(6); PG8_BAR; PG8_MMA(1, 1, At, B1); PG8_BAR;
            }
        }
        if constexpr (ALIGN_EPI) { if (wr == 0) PG8_BAR; }
        if constexpr (!Epi::AFTER_DRAIN) { E(acc, cur, wr, wc, fr, fq); S.done(cur); }
        if (!has_next) break;
#pragma unroll
        for (int a = 0; a < 2; ++a)
#pragma unroll
            for (int b = 0; b < 2; ++b)
#pragma unroll
                for (int m = 0; m < 4; ++m)
#pragma unroll
                    for (int n = 0; n < 2; ++n) acc[a][b][m][n] = (f32x4){0.f, 0.f, 0.f, 0.f};
        cur = nxt; cA = nA; cB = nB; ++ui;
        if constexpr (ALIGN_EPI) { if (wr == 1) PG8_BAR; }
    }
    PG8_WAIT_V(0);
    if constexpr (!ALIGN_EPI) { if (wr == 0) PG8_BAR; }
    PG8_BAR;
    if constexpr (Epi::AFTER_DRAIN) { E.fused(acc, cur, wr, wc, fr, fq, lds, wid, lane); S.done(cur); }
#undef PG8_SA
#undef PG8_SB
#undef PG8_STAGE
#undef PG8_LDA
#undef PG8_LDB
#undef PG8_MMA
#undef PG8_WAIT_V
#undef PG8_WAIT_L
#undef PG8_BAR
#undef PG8_SCHED
}
}

#define LAS __attribute__((address_space(3)))
typedef unsigned short bf16_t;
typedef short bf16x8 __attribute__((ext_vector_type(8)));
typedef short s16x4 __attribute__((ext_vector_type(4)));
typedef float f32x4 __attribute__((ext_vector_type(4)));
typedef float f32x16 __attribute__((ext_vector_type(16)));
typedef unsigned u32x4 __attribute__((ext_vector_type(4)));
typedef unsigned u32x2 __attribute__((ext_vector_type(2)));

constexpr int SEQ = 8192, DM = 2048, MTOK = 16384, DFF = 5632, NQKV = 6144, HD = 128;
constexpr size_t SZ_WIN = (size_t)2 * DFF * DM * 2, SZ_WOUT = (size_t)DM * DFF * 2, SZ_WMIN = (size_t)NQKV * DM * 2, SZ_WMOUT = (size_t)DM * DM * 2;
constexpr size_t WS_FFA_IN = 0, WS_FFA_OUT = WS_FFA_IN + 2 * SZ_WIN, WS_FFB_IN = WS_FFA_OUT + 2 * SZ_WOUT, WS_FFB_OUT = WS_FFB_IN + 2 * SZ_WIN;
constexpr size_t WS_MIX_IN = WS_FFB_OUT + 2 * SZ_WOUT, WS_MIX_OUT = WS_MIX_IN + 2 * SZ_WMIN;
constexpr size_t WS_XN = WS_MIX_OUT + 2 * SZ_WMOUT;
constexpr size_t WS_BIG = WS_XN + (size_t)MTOK * DM * 2;
constexpr size_t WS_ATT = WS_BIG + (size_t)MTOK * NQKV * 2;
constexpr size_t WS_PART = WS_ATT + (size_t)MTOK * DM * 2;
constexpr size_t WS_LSE = WS_PART + (size_t)3 * MTOK * 1024 * 2;
constexpr size_t WS_ROPE = WS_LSE + (size_t)3 * MTOK * 8 * 4;
constexpr size_t WS_KMEAN = WS_ROPE + (size_t)2 * SEQ * 64 * 4;
constexpr size_t WS_CTL = WS_KMEAN + (size_t)2 * 8 * 32 * 128 * 4, CTL_BYTES = 16384;
constexpr size_t WS_END = WS_CTL + CTL_BYTES;

#ifndef REP_ATT
#define REP_ATT 1
#endif
#ifndef REP_DIL
#define REP_DIL REP_ATT
#endif
#ifndef REP_MOBA
#define REP_MOBA REP_ATT
#endif
#ifndef REP_DIFF
#define REP_DIFF REP_ATT
#endif
#ifndef REP_PRO
#define REP_PRO 1
#endif
#ifndef REP_SWI
#define REP_SWI 1
#endif
#ifndef REP_QKV
#define REP_QKV 1
#endif
#ifndef REP_NORM
#define REP_NORM 1
#endif
#ifndef REP_RES
#define REP_RES 1
#endif
#ifndef REP_SYNC
#define REP_SYNC 1
#endif
#define GSYNC() do { for (int rs_ = 0; rs_ < REP_SYNC; ++rs_) { int l_; asm volatile("v_mbcnt_lo_u32_b32 %0, -1, 0\n\tv_mbcnt_hi_u32_b32 %0, -1, %0" : "=v"(l_)); xcd_barrier(xbar, (l_ + wave_s * 64) == 0); } } while (0)
constexpr int LDS_BYTES = 153600;

struct Params {
    const float* in[18];
    float* out; unsigned char* ws;
};

__device__ __forceinline__ unsigned f2bf(float f) { unsigned u = __builtin_bit_cast(unsigned, f); return (u + 0x7fffu + ((u >> 16) & 1u)) >> 16; }
__device__ __forceinline__ unsigned pk2(float lo, float hi) { return f2bf(lo) | (f2bf(hi) << 16); }
__device__ __forceinline__ float bf2f(unsigned short b) { return __builtin_bit_cast(float, (unsigned)b << 16); }
__device__ __forceinline__ int shfl_xor_i(int v, int o, int lane) { return __builtin_amdgcn_ds_bpermute((lane ^ o) << 2, v); }
__device__ __forceinline__ float shfl_xor_f(float v, int o, int lane) { return __int_as_float(__builtin_amdgcn_ds_bpermute((lane ^ o) << 2, __float_as_int(v))); }
__device__ __forceinline__ float wave_sum(float v, int lane) {
#pragma unroll
    for (int o = 1; o < 64; o <<= 1) v += shfl_xor_f(v, o, lane);
    return v;
}

template <int MODE>
__device__ __forceinline__ int src_col(int n, unsigned long long ropemask) {
    if (MODE == 0) return n;
    if (MODE == 1) { const int pn = n >> 8, cc = n & 255; return cc < 128 ? pn * 128 + cc : DFF + pn * 128 + (cc - 128); }
    const int hg = n >> 7, p = n & 127;
    if ((ropemask >> hg) & 1ull) return hg * 128 + ((p & 1) ? 64 + (p >> 1) : (p >> 1));
    return n;
}
template <int MODE>
__device__ __forceinline__ void transpose_items(const float* W, int K, int N, bf16_t* WT, unsigned long long ropemask, LAS float* scr, int gw, int NGW, int lane) {
    const int nblk = N / 32, nitems = (K / 64) * nblk;
    for (int item = gw; item < nitems; item += NGW) {
        const int kb = item / nblk, nb = item % nblk, k0 = 64 * kb, n0 = 32 * nb;
        const int sc = src_col<MODE>(n0 + (lane & 31), ropemask);
#pragma unroll
        for (int i = 0; i < 32; ++i) { const int kk = 2 * i + (lane >> 5); scr[kk * 33 + (lane & 31)] = W[(size_t)(k0 + kk) * N + sc]; }
        asm volatile("s_waitcnt lgkmcnt(0)" ::: "memory");
        const int c = lane & 7;
#pragma unroll
        for (int j = 0; j < 4; ++j) { const int n = (lane >> 3) + 8 * j; const LAS float* s = scr + (8 * c) * 33 + n;
            u32x4 o; o.x = pk2(s[0 * 33], s[1 * 33]); o.y = pk2(s[2 * 33], s[3 * 33]); o.z = pk2(s[4 * 33], s[5 * 33]); o.w = pk2(s[6 * 33], s[7 * 33]);
            *(u32x4*)(WT + (size_t)(n0 + n) * K + k0 + 8 * c) = o; }
        asm volatile("s_waitcnt lgkmcnt(0)" ::: "memory");
    }
}

template <bool OUT_F32>
__device__ __forceinline__ void norm_phase(const float* src, const float* gain, void* dst, int gw, int NGW, int lane) {
    f32x4 g[8];
#pragma unroll
    for (int j = 0; j < 8; ++j) g[j] = ((const f32x4*)gain)[lane + 64 * j];
    for (int row = gw; row < MTOK; row += 2 * NGW) {
        const f32x4* xr0 = (const f32x4*)(src + (size_t)row * DM) + lane;
        const int rowb = (row + NGW < MTOK) ? row + NGW : row;
        const f32x4* xr1 = (const f32x4*)(src + (size_t)rowb * DM) + lane;
        f32x4 v0[8], v1[8]; float s0 = 0.f, s1 = 0.f;
#pragma unroll
        for (int j = 0; j < 8; ++j) { v0[j] = xr0[64 * j]; v1[j] = xr1[64 * j]; }
#pragma unroll
        for (int j = 0; j < 8; ++j) { s0 += (v0[j].x * v0[j].x + v0[j].y * v0[j].y) + (v0[j].z * v0[j].z + v0[j].w * v0[j].w); s1 += (v1[j].x * v1[j].x + v1[j].y * v1[j].y) + (v1[j].z * v1[j].z + v1[j].w * v1[j].w); }
        const float r0 = 1.0f / sqrtf(wave_sum(s0, lane) * (1.0f / DM) + 1e-6f), r1 = 1.0f / sqrtf(wave_sum(s1, lane) * (1.0f / DM) + 1e-6f);
        if (OUT_F32) { f32x4* o0 = (f32x4*)((float*)dst + (size_t)row * DM) + lane; f32x4* o1 = (f32x4*)((float*)dst + (size_t)rowb * DM) + lane;
#pragma unroll
            for (int j = 0; j < 8; ++j) { o0[64 * j] = v0[j] * r0 * g[j]; o1[64 * j] = v1[j] * r1 * g[j]; }
        } else { u32x2* o0 = (u32x2*)((bf16_t*)dst + (size_t)row * DM) + lane; u32x2* o1 = (u32x2*)((bf16_t*)dst + (size_t)rowb * DM) + lane;
#pragma unroll
            for (int j = 0; j < 8; ++j) { const f32x4 y0 = v0[j] * r0 * g[j], y1 = v1[j] * r1 * g[j]; u32x2 w0, w1; w0.x = pk2(y0.x, y0.y); w0.y = pk2(y0.z, y0.w); w1.x = pk2(y1.x, y1.y); w1.y = pk2(y1.z, y1.w); o0[64 * j] = w0; o1[64 * j] = w1; } }
    }
}

namespace att {
constexpr int KSTR = 272, VSTR = 320, KBYTES = 64 * KSTR, VBYTES = 64 * VSTR;
constexpr float SC = 0.08838834764831845f * 1.4426950408889634f;
constexpr float NEG = -1e30f;
constexpr float NEGR = -1e6f;
__device__ __forceinline__ int crow(int e, int hi) { return (e & 3) + 8 * (e >> 2) + 4 * hi; }
typedef float f32x2_t __attribute__((ext_vector_type(2))); typedef __bf16 bf16x2_t __attribute__((ext_vector_type(2)));
__device__ __forceinline__ unsigned cvtpk(float lo, float hi) { f32x2_t v = {lo, hi}; bf16x2_t b = __builtin_convertvector(v, bf16x2_t); return __builtin_bit_cast(unsigned, b); }
__device__ __forceinline__ float xhalf_max(float v) { auto rr = __builtin_amdgcn_permlane32_swap(__float_as_uint(v), __float_as_uint(v), false, false); return fmaxf(__uint_as_float(rr[0]), __uint_as_float(rr[1])); }
__device__ __forceinline__ float xhalf_sum(float v) { auto rr = __builtin_amdgcn_permlane32_swap(__float_as_uint(v), __float_as_uint(v), false, false); return __uint_as_float(rr[0]) + __uint_as_float(rr[1]); }
__device__ __forceinline__ float max3f(float a, float b, float c) { float r; asm("v_max3_f32 %0, %1, %2, %3" : "=v"(r) : "v"(a), "v"(b), "v"(c)); return r; }
__device__ __forceinline__ float max2f(float a, float b) { float r; asm("v_max_f32_e32 %0, %1, %2" : "=v"(r) : "v"(a), "v"(b)); return r; }
__device__ __forceinline__ float fadd_s(float a, float b) { float r; asm("v_add_f32_e32 %0, %1, %2" : "=v"(r) : "v"(a), "v"(b)); return r; }
__device__ __forceinline__ bf16x8 pack8(const f32x16& s, int o) {
    u32x4 w; w.x = cvtpk(s[o + 0], s[o + 1]); w.y = cvtpk(s[o + 2], s[o + 3]); w.z = cvtpk(s[o + 4], s[o + 5]); w.w = cvtpk(s[o + 6], s[o + 7]);
    return __builtin_bit_cast(bf16x8, w);
}
__device__ __forceinline__ s16x4 vtr(const LAS unsigned char* p) { return __builtin_bit_cast(s16x4, __builtin_amdgcn_ds_read_tr16_b64_v4i16((LAS s16x4*)p)); }

__device__ __forceinline__ void load_q(bf16x8 (&qf)[8], const bf16_t* Qp, long qrow, int hi) {
    const bf16_t* p = Qp + qrow * NQKV + 8 * hi;
#pragma unroll
    for (int c = 0; c < 8; ++c) qf[c] = *(const bf16x8*)(p + 16 * c);
}

#ifndef PF_AHEAD
#define PF_AHEAD 3
#endif
struct Stage { u32x4 kreg[2], vreg[2]; };
template <class TS>
__device__ __forceinline__ void m_block(LAS unsigned char* lds, const TS& ts, int tau, int nt, const bf16x8 (&qf)[8], f32x16 (&O)[4], f32x16& s0, f32x16& s1, const bf16x8 (&P)[4], int kro, int vro) {
#pragma unroll
    for (int e = 0; e < 16; ++e) { s0[e] = 0.f; s1[e] = 0.f; }
#ifdef PROBE_MFMA2
    f32x16 dmy;
#pragma unroll
    for (int e = 0; e < 16; ++e) dmy[e] = 0.f;
#endif
    const bool qk_on = tau + 1 < nt && ts.active(tau + 1);
    const LAS unsigned char* kb = lds + ((tau + 1) & 1) * KBYTES + kro;
    bf16x8 fk[2][4];
    if (qk_on) {
#pragma unroll
        for (int j = 0; j < 2; ++j) { fk[0][2 * j] = *(const LAS bf16x8*)(kb + j * 32); fk[0][2 * j + 1] = *(const LAS bf16x8*)(kb + 32 * KSTR + j * 32); }
    }
    __builtin_amdgcn_sched_barrier(0);
    if (tau >= 0 && ts.active(tau)) {
        const LAS unsigned char* vb = lds + 2 * KBYTES + (tau & 1) * VBYTES + vro;
        s16x4 fl[2][4], fh[2][4];
#pragma unroll
        for (int b = 0; b < 4; ++b) { fl[0][b] = vtr(vb + b * 64); fh[0][b] = vtr(vb + 8 * VSTR + b * 64); }
        __builtin_amdgcn_sched_barrier(0);
#pragma unroll
        for (int q = 0; q < 4; ++q) {
            if (q < 3) {
#pragma unroll
                for (int b = 0; b < 4; ++b) { fl[(q + 1) & 1][b] = vtr(vb + (16 * (q + 1)) * VSTR + b * 64); fh[(q + 1) & 1][b] = vtr(vb + (16 * (q + 1) + 8) * VSTR + b * 64); }
            }
#pragma unroll
            for (int b = 0; b < 4; ++b) {
                const s16x4 lo = fl[q & 1][b], hh = fh[q & 1][b];
                const bf16x8 vf = (bf16x8){lo[0], lo[1], lo[2], lo[3], hh[0], hh[1], hh[2], hh[3]};
                O[b] = __builtin_amdgcn_mfma_f32_32x32x16_bf16(vf, P[q], O[b], 0, 0, 0);
#ifdef PROBE_MFMA2
                dmy = __builtin_amdgcn_mfma_f32_32x32x16_bf16(vf, P[q], dmy, 0, 0, 0);
#endif
            }
            __builtin_amdgcn_sched_barrier(0);
        }
    }
    if (qk_on) {
#pragma unroll
        for (int c2 = 0; c2 < 4; ++c2) {
            if (c2 < 3) {
#pragma unroll
                for (int j = 0; j < 2; ++j) { fk[(c2 + 1) & 1][2 * j] = *(const LAS bf16x8*)(kb + (2 * (c2 + 1) + j) * 32); fk[(c2 + 1) & 1][2 * j + 1] = *(const LAS bf16x8*)(kb + 32 * KSTR + (2 * (c2 + 1) + j) * 32); }
            }
#pragma unroll
            for (int j = 0; j < 2; ++j) {
                s0 = __builtin_amdgcn_mfma_f32_32x32x16_bf16(fk[c2 & 1][2 * j], qf[2 * c2 + j], s0, 0, 0, 0);
                s1 = __builtin_amdgcn_mfma_f32_32x32x16_bf16(fk[c2 & 1][2 * j + 1], qf[2 * c2 + j], s1, 0, 0, 0);
#ifdef PROBE_MFMA2
                dmy = __builtin_amdgcn_mfma_f32_32x32x16_bf16(fk[c2 & 1][2 * j], qf[2 * c2 + j], dmy, 0, 0, 0);
                dmy = __builtin_amdgcn_mfma_f32_32x32x16_bf16(fk[c2 & 1][2 * j + 1], qf[2 * c2 + j], dmy, 0, 0, 0);
#endif
            }
            __builtin_amdgcn_sched_barrier(0);
        }
    }
#ifdef PROBE_MFMA2
    asm volatile("" :: "v"(dmy));
#endif
}
template <class TS>
__device__ __forceinline__ void v_block(LAS unsigned char* lds, const TS& ts, int tau, int ct, int nt, const bf16_t* Kp, const bf16_t* Vp, long krow0, int kstride, Stage& st,
                                        f32x16 (&O)[4], f32x16& s0, f32x16& s1, bf16x8 (&P)[4], float& m, float& l, int sr, int sc16, int hi) {
    asm volatile("" : "+v"(sr), "+v"(sc16));
#define ATT_ROW(t_, i_) ({ int kp_ = ts.kstart(t_) + sr + 32 * (i_); if (TS::CLAMP) kp_ = kp_ < 0 ? 0 : kp_; ((unsigned)((int)krow0 + kp_ * kstride) * (unsigned)NQKV + (unsigned)(sc16 * 8)) * 2u; })
#define ATT_ISSUE_K(t_) do { if ((t_) >= 0 && (t_) < nt) { _Pragma("unroll") for (int i_ = 0; i_ < 2; ++i_) st.kreg[i_] = *(const u32x4*)((const char*)Kp + ATT_ROW(t_, i_)); } } while (0)
#define ATT_ISSUE_V(t_) do { if ((t_) >= 0 && (t_) < nt) { _Pragma("unroll") for (int i_ = 0; i_ < 2; ++i_) st.vreg[i_] = *(const u32x4*)((const char*)Vp + ATT_ROW(t_, i_)); } } while (0)
#define ATT_COMMIT_K(t_) do { if ((t_) >= 0 && (t_) < nt) { _Pragma("unroll") for (int i_ = 0; i_ < 2; ++i_) *(LAS u32x4*)(lds + ((t_) & 1) * KBYTES + (sr + 32 * i_) * KSTR + sc16 * 16) = st.kreg[i_]; } } while (0)
#define ATT_COMMIT_V(t_) do { if ((t_) >= 0 && (t_) < nt) { _Pragma("unroll") for (int i_ = 0; i_ < 2; ++i_) *(LAS u32x4*)(lds + 2 * KBYTES + ((t_) & 1) * VBYTES + (sr + 32 * i_) * VSTR + sc16 * 16) = st.vreg[i_]; } } while (0)
    ATT_COMMIT_K(ct); ATT_COMMIT_V(ct - 1);
    ATT_ISSUE_K(ct + 1); ATT_ISSUE_V(ct);
#ifdef USE_L2_PREFETCH
    if ((sc16 & 7) == 0) {
        if (ct + 1 + PF_AHEAD < nt) { _Pragma("unroll") for (int i_ = 0; i_ < 2; ++i_) (void)*(const volatile unsigned*)((const char*)Kp + ATT_ROW(ct + 1 + PF_AHEAD, i_)); }
        if (ct + PF_AHEAD < nt && ct + PF_AHEAD >= 0) { _Pragma("unroll") for (int i_ = 0; i_ < 2; ++i_) (void)*(const volatile unsigned*)((const char*)Vp + ATT_ROW(ct + PF_AHEAD, i_)); }
    }
#endif
    const int t = tau + 1;
    if (t >= 0 && t < nt && ts.active(t)) {
        __builtin_amdgcn_s_setprio(1);
        const int ks = ts.kstart(t);
        if (ts.need_mask(t)) {
#pragma unroll
            for (int e = 0; e < 16; ++e) {
                const int kp0 = ks + crow(e, hi), kp1 = kp0 + 32;
                s0[e] = ts.valid(t, ks, kp0) ? s0[e] : NEGR; s1[e] = ts.valid(t, ks, kp1) ? s1[e] : NEGR;
            }
        }
        float mxa = max3f(s0[0], s0[1], s1[0]), mxb = max3f(s0[2], s0[3], s1[1]);
        mxa = max3f(mxa, s1[2], s1[3]);
#pragma unroll
        for (int e = 4; e < 16; e += 4) { mxa = max3f(mxa, s0[e], s0[e + 1]); mxb = max3f(mxb, s0[e + 2], s0[e + 3]); mxa = max3f(mxa, s1[e], s1[e + 1]); mxb = max3f(mxb, s1[e + 2], s1[e + 3]); }
        float mx = max2f(mxa, mxb);
        mx = xhalf_max(mx);
        const float mn = max2f(m, mx * SC);
        if (__any(mn > m)) {
            const float a = __builtin_amdgcn_exp2f(m - mn); l *= a; m = mn;
#pragma unroll
            for (int b = 0; b < 4; ++b)
#pragma unroll
                for (int e = 0; e < 16; ++e) O[b][e] *= a;
        }
        float ps = 0.f, ps1 = 0.f;
#pragma unroll
        for (int e = 0; e < 16; ++e) { s0[e] = __builtin_amdgcn_exp2f(__builtin_fmaf(s0[e], SC, -m)); s1[e] = __builtin_amdgcn_exp2f(__builtin_fmaf(s1[e], SC, -m)); ps += s0[e]; ps1 += s1[e]; }
        l += ps + ps1;
#ifdef PROBE_EXP2
        { float d2 = 0.f;
#pragma unroll
          for (int e = 0; e < 16; ++e) d2 += __builtin_amdgcn_exp2f(s0[e] * 0.5f) + __builtin_amdgcn_exp2f(s1[e] * 0.5f);
          asm volatile("" :: "v"(d2)); }
#endif
        P[0] = pack8(s0, 0); P[1] = pack8(s0, 8); P[2] = pack8(s1, 0); P[3] = pack8(s1, 8);
        __builtin_amdgcn_s_setprio(0);
    }
}
template <class TS>
__device__ __forceinline__ void flash_pass(LAS unsigned char* lds, const bf16_t* Kp, const bf16_t* Vp, long krow0, int kstride,
                                           const bf16x8 (&qf)[8], const TS& ts, f32x16 (&O)[4], float& m, float& l, const int tid) {
#define ATT_BAR() do { asm volatile("s_waitcnt lgkmcnt(0)" ::: "memory"); __builtin_amdgcn_s_barrier(); asm volatile("" ::: "memory"); } while (0)
    const int lane = tid & 63, hi = lane >> 5, grp = __builtin_amdgcn_readfirstlane(tid >> 8);
    const int sr = tid >> 4, sc16 = tid & 15;
    Stage st;
    const int nt = ts.n();
    ATT_ISSUE_K(0); ATT_COMMIT_K(0); ATT_ISSUE_K(1); ATT_ISSUE_V(0);
    ATT_BAR();
    const int kro = (lane & 31) * KSTR + hi * 16;
    const int vro = (4 * hi + ((lane & 15) >> 2)) * VSTR + (((lane >> 4) & 1) * 16 + (lane & 3) * 4) * 2;
    f32x16 s0, s1; bf16x8 P[4];
#pragma unroll
    for (int q = 0; q < 4; ++q) P[q] = (bf16x8){0, 0, 0, 0, 0, 0, 0, 0};
    if (grp == 0) {
        for (int tau = -1; tau < nt; ++tau) {
            m_block(lds, ts, tau, nt, qf, O, s0, s1, P, kro, vro);
            v_block(lds, ts, tau, tau + 2, nt, Kp, Vp, krow0, kstride, st, O, s0, s1, P, m, l, sr, sc16, hi);
            ATT_BAR();
        }
    } else {
        for (int tau = -1; tau < nt; ++tau) {
            v_block(lds, ts, tau - 1, tau + 2, nt, Kp, Vp, krow0, kstride, st, O, s0, s1, P, m, l, sr, sc16, hi);
            m_block(lds, ts, tau, nt, qf, O, s0, s1, P, kro, vro);
            ATT_BAR();
        }
    }
#undef ATT_BAR
#undef ATT_ROW
#undef ATT_ISSUE_K
#undef ATT_ISSUE_V
#undef ATT_COMMIT_K
#undef ATT_COMMIT_V
}

__device__ __forceinline__ void zero_state(f32x16 (&O)[4], float& m, float& l) {
#pragma unroll
    for (int b = 0; b < 4; ++b)
#pragma unroll
        for (int e = 0; e < 16; ++e) O[b][e] = 0.f;
    m = NEG; l = 0.f;
}
__device__ __forceinline__ void store_o(const f32x16 (&O)[4], float scale, bf16_t* dst, int hi) {
#pragma unroll
    for (int b = 0; b < 4; ++b)
#pragma unroll
        for (int g = 0; g < 4; ++g) { u32x2 w; w.x = cvtpk(O[b][4 * g] * scale, O[b][4 * g + 1] * scale); w.y = cvtpk(O[b][4 * g + 2] * scale, O[b][4 * g + 3] * scale);
            *(u32x2*)(dst + 32 * b + 8 * g + 4 * hi) = w; }
}

struct TSDil {
    static constexpr bool CLAMP = true;
    int k0, qlo, qpos;
    __device__ __forceinline__ int n() const { return 6; }
    __device__ __forceinline__ int kstart(int t) const { return k0 + 64 * t; }
    __device__ __forceinline__ bool active(int t) const { const int ks = k0 + 64 * t; return ks <= qlo + 31 && ks + 63 >= qlo - 128; }
    __device__ __forceinline__ bool need_mask(int) const { return true; }
    __device__ __forceinline__ bool valid(int, int, int kpos) const { const int d = qpos - kpos; return d >= 0 && d <= 128 && kpos >= 0; }
};
struct TSCausal {
    static constexpr bool CLAMP = false;
    int nt, qpos, wqhi;
    __device__ __forceinline__ int n() const { return nt; }
    __device__ __forceinline__ int kstart(int t) const { return 64 * t; }
    __device__ __forceinline__ bool active(int t) const { return 64 * t <= wqhi; }
    __device__ __forceinline__ bool need_mask(int t) const { return 64 * t + 63 > wqhi - 31; }
    __device__ __forceinline__ bool valid(int, int, int kpos) const { return kpos <= qpos; }
};
struct TSMoba {
    static constexpr bool CLAMP = false;
    const LAS int* list; int nt, qb, qpos, wqhi; unsigned wmask, lmask, amask;
    __device__ __forceinline__ int n() const { return nt; }
    __device__ __forceinline__ int kstart(int t) const { return list[t]; }
    __device__ __forceinline__ bool active(int t) const { const int ks = list[t], blk = ks >> 8; return blk == qb ? ks <= wqhi : ((wmask >> blk) & 1u) != 0u; }
    __device__ __forceinline__ bool need_mask(int t) const { const int ks = list[t], blk = ks >> 8; return blk == qb ? ks + 63 > wqhi - 31 : ((amask >> blk) & 1u) == 0u; }
    __device__ __forceinline__ bool valid(int, int ks, int kpos) const { const int blk = ks >> 8; return blk == qb ? kpos <= qpos : ((lmask >> blk) & 1u) != 0u; }
};

#ifndef DP_SOFTMAX_COLS
#define DP_SOFTMAX_COLS 64
#endif
constexpr int DP_NBP = DP_SOFTMAX_COLS / 32, DP_NBC = 8 - DP_NBP;
constexpr int VS2 = 576, VB2 = 64 * VS2, DP_V = 2 * KBYTES, DP_P = DP_V + 2 * VB2, DP_PW = 5120, DP_PSLOT = 4 * DP_PW, DP_END = DP_P + 2 * DP_PSLOT;
#define DP_BAR() do { asm volatile("s_waitcnt lgkmcnt(0)" ::: "memory"); __builtin_amdgcn_s_barrier(); asm volatile("" ::: "memory"); } while (0)
template <int NB, int B0>
__device__ __forceinline__ void dp_pv(f32x16 (&O)[NB], const LAS unsigned char* vb, const bf16x8 (&P)[4]) {
    constexpr int NP = NB / 2, NS = 4 * NP;
    s16x4 fl[2][2], fh[2][2];
#pragma unroll
    for (int b = 0; b < 2; ++b) { fl[0][b] = vtr(vb + (B0 + b) * 64); fh[0][b] = vtr(vb + 8 * VS2 + (B0 + b) * 64); }
    __builtin_amdgcn_sched_barrier(0);
#pragma unroll
    for (int st = 0; st < NS; ++st) {
        const int q = st / NP, bp = st % NP;
        if (st < NS - 1) {
            const int qn = (st + 1) / NP, bn = (st + 1) % NP;
#pragma unroll
            for (int b = 0; b < 2; ++b) { fl[(st + 1) & 1][b] = vtr(vb + (16 * qn) * VS2 + (B0 + 2 * bn + b) * 64); fh[(st + 1) & 1][b] = vtr(vb + (16 * qn + 8) * VS2 + (B0 + 2 * bn + b) * 64); }
        }
#pragma unroll
        for (int b = 0; b < 2; ++b) {
            const s16x4 lo = fl[st & 1][b], hh = fh[st & 1][b];
            const bf16x8 vf = (bf16x8){lo[0], lo[1], lo[2], lo[3], hh[0], hh[1], hh[2], hh[3]};
            O[2 * bp + b] = __builtin_amdgcn_mfma_f32_32x32x16_bf16(vf, P[q], O[2 * bp + b], 0, 0, 0);
        }
        __builtin_amdgcn_sched_barrier(0);
    }
}
template <int NB, int B0>
__device__ __forceinline__ void dp_post(f32x16 (&O)[NB], const float inv_l, const int pr, const float lam, const float post_scale, float* parkt, const float* sg, bf16_t* dst,
                                        LAS float* ssx, const int tid, const int hi) {
    f32x4* pk = (f32x4*)parkt;
    if (pr == 0) {
#pragma unroll
        for (int bb = 0; bb < NB; ++bb)
#pragma unroll
            for (int g4 = 0; g4 < 4; ++g4) pk[bb * 4 + g4] = (f32x4){O[bb][4 * g4], O[bb][4 * g4 + 1], O[bb][4 * g4 + 2], O[bb][4 * g4 + 3]} * inv_l;
    } else {
        float ss = 0.f;
#pragma unroll
        for (int bb = 0; bb < NB; ++bb)
#pragma unroll
            for (int g4 = 0; g4 < 4; ++g4) { const f32x4 pv = pk[bb * 4 + g4];
#pragma unroll
                for (int i = 0; i < 4; ++i) { const float v = pv[i] - lam * (O[bb][4 * g4 + i] * inv_l); O[bb][4 * g4 + i] = v; ss += v * v; } }
        ss = xhalf_sum(ss);
        ssx[tid] = ss;
        DP_BAR();
        ss += ssx[tid ^ 256];
        DP_BAR();
        const float rs = post_scale / sqrtf(ss * (1.0f / 256.0f) + 1e-5f);
#pragma unroll
        for (int bb = 0; bb < NB; ++bb)
#pragma unroll
            for (int g4 = 0; g4 < 4; ++g4) {
                const int dv = 32 * (B0 + bb) + 8 * g4 + 4 * hi;
                const f32x4 ga = *(const f32x4*)(sg + dv);
                u32x2 w; w.x = cvtpk(O[bb][4 * g4] * ga[0] * rs, O[bb][4 * g4 + 1] * ga[1] * rs); w.y = cvtpk(O[bb][4 * g4 + 2] * ga[2] * rs, O[bb][4 * g4 + 3] * ga[3] * rs);
                *(u32x2*)(dst + dv) = w;
            }
    }
}
__device__ __forceinline__ void diff_pass(LAS unsigned char* lds, const bf16_t* Kp, const bf16_t* Vp, const bf16_t* Qp, const int row0, const int qb, const int pr, const float lam, const float post_scale,
                                          float* park, const float* sg, bf16_t* att_head  , const int tid) {
    const int lane = tid & 63, hi = lane >> 5, grp = __builtin_amdgcn_readfirstlane(tid >> 8), pw = __builtin_amdgcn_readfirstlane(tid >> 6) & 3;
    const int nt = 2 * (qb + 1), qlo = 128 * qb + 32 * pw, qpos = qlo + (lane & 31), wqhi = qlo + 31;
    LAS unsigned char* pbase = lds + DP_P + pw * DP_PW + lane * 16;
    LAS float* ssx = (LAS float*)(lds + DP_END);
    const int vro = (4 * hi + ((lane & 15) >> 2)) * VS2 + (((lane >> 4) & 1) * 16 + (lane & 3) * 4) * 2;
    int vr = (tid - 256) >> 5, vc = tid & 31, sr = (tid - 256) >> 4, sc16 = tid & 15;
    asm volatile("" : "+v"(vr), "+v"(vc), "+v"(sr), "+v"(sc16));
#define DP_VOFF(t_, i_) (((unsigned)(row0 + 64 * (t_) + vr + 8 * (i_)) * (unsigned)NQKV + (unsigned)(vc * 8)) * 2u)
#define DP_ISSUE_V(t_) do { if ((t_) < nt) { _Pragma("unroll") for (int i_ = 0; i_ < 8; ++i_) vreg[i_] = *(const u32x4*)((const char*)Vp + DP_VOFF(t_, i_)); } } while (0)
#define DP_COMMIT_V(t_) do { if ((t_) < nt) { _Pragma("unroll") for (int i_ = 0; i_ < 8; ++i_) *(LAS u32x4*)(lds + DP_V + ((t_) & 1) * VB2 + (vr + 8 * i_) * VS2 + vc * 16) = vreg[i_]; } } while (0)
#define DP_KOFF(t_, i_) (((unsigned)(row0 + 64 * (t_) + sr + 16 * (i_)) * (unsigned)NQKV + (unsigned)(sc16 * 8)) * 2u)
#define DP_ISSUE_K(t_) do { if ((t_) < nt) { _Pragma("unroll") for (int i_ = 0; i_ < 4; ++i_) kreg[i_] = *(const u32x4*)((const char*)Kp + DP_KOFF(t_, i_)); } } while (0)
#define DP_COMMIT_K(t_) do { if ((t_) < nt) { _Pragma("unroll") for (int i_ = 0; i_ < 4; ++i_) *(LAS u32x4*)(lds + ((t_) & 1) * KBYTES + (sr + 16 * i_) * KSTR + sc16 * 16) = kreg[i_]; } } while (0)
    if (grp == 0) {
        bf16x8 qf[8]; load_q(qf, Qp, (long)row0 + qpos, hi);
        DP_BAR();
        const int kro = (lane & 31) * KSTR + hi * 16;
        f32x16 O[2]; f32x16 s0, s1; bf16x8 P[4]; float m = NEG, l = 0.f;
#pragma unroll
        for (int e = 0; e < 16; ++e) { O[0][e] = 0.f; O[1][e] = 0.f; }
        (void)O;
#pragma unroll
        for (int q = 0; q < 4; ++q) P[q] = (bf16x8){0, 0, 0, 0, 0, 0, 0, 0};
        for (int tau = -1; tau < nt; ++tau) {
            if (DP_NBP == 2) { if (tau >= 0 && 64 * tau <= wqhi) dp_pv<2, 0>(O, lds + DP_V + (tau & 1) * VB2 + vro, P); }
#pragma unroll
            for (int e = 0; e < 16; ++e) { s0[e] = 0.f; s1[e] = 0.f; }
            const int t = tau + 1;
            const bool act = t < nt && 64 * t <= wqhi;
            if (act) {
                const LAS unsigned char* kb = lds + (t & 1) * KBYTES + kro;
                bf16x8 fk[2][4];
#pragma unroll
                for (int j = 0; j < 2; ++j) { fk[0][2 * j] = *(const LAS bf16x8*)(kb + j * 32); fk[0][2 * j + 1] = *(const LAS bf16x8*)(kb + 32 * KSTR + j * 32); }
                __builtin_amdgcn_sched_barrier(0);
#pragma unroll
                for (int c2 = 0; c2 < 4; ++c2) {
                    if (c2 < 3) {
#pragma unroll
                        for (int j = 0; j < 2; ++j) { fk[(c2 + 1) & 1][2 * j] = *(const LAS bf16x8*)(kb + (2 * (c2 + 1) + j) * 32); fk[(c2 + 1) & 1][2 * j + 1] = *(const LAS bf16x8*)(kb + 32 * KSTR + (2 * (c2 + 1) + j) * 32); }
                    }
#pragma unroll
                    for (int j = 0; j < 2; ++j) {
                        s0 = __builtin_amdgcn_mfma_f32_32x32x16_bf16(fk[c2 & 1][2 * j], qf[2 * c2 + j], s0, 0, 0, 0);
                        s1 = __builtin_amdgcn_mfma_f32_32x32x16_bf16(fk[c2 & 1][2 * j + 1], qf[2 * c2 + j], s1, 0, 0, 0);
                    }
                    __builtin_amdgcn_sched_barrier(0);
                }
            }
            if (act) {
                const int ks = 64 * t;
                if (ks + 63 > qlo) {
#pragma unroll
                    for (int e = 0; e < 16; ++e) { const int kp0 = ks + crow(e, hi), kp1 = kp0 + 32; s0[e] = kp0 <= qpos ? s0[e] : NEGR; s1[e] = kp1 <= qpos ? s1[e] : NEGR; }
                }
                float mxa = max3f(s0[0], s0[1], s1[0]), mxb = max3f(s0[2], s0[3], s1[1]);
                mxa = max3f(mxa, s1[2], s1[3]);
#pragma unroll
                for (int e = 4; e < 16; e += 4) { mxa = max3f(mxa, s0[e], s0[e + 1]); mxb = max3f(mxb, s0[e + 2], s0[e + 3]); mxa = max3f(mxa, s1[e], s1[e + 1]); mxb = max3f(mxb, s1[e + 2], s1[e + 3]); }
                float mx = max2f(mxa, mxb);
                mx = xhalf_max(mx);
                const float mn = max2f(m, mx * SC);
                const float a = __builtin_amdgcn_exp2f(m - mn);
                if (DP_NBP == 2) {
                    if (__any(mn > m)) {
                        l *= a; m = mn;
#pragma unroll
                        for (int e = 0; e < 16; ++e) { O[0][e] *= a; O[1][e] *= a; }
                    }
                } else { l *= a; m = mn; }
                float ps = 0.f, ps1 = 0.f;
#pragma unroll
                for (int e = 0; e < 16; ++e) { s0[e] = __builtin_amdgcn_exp2f(__builtin_fmaf(s0[e], SC, -m)); s1[e] = __builtin_amdgcn_exp2f(__builtin_fmaf(s1[e], SC, -m)); ps += s0[e]; ps1 += s1[e]; }
                l += ps + ps1;
                P[0] = pack8(s0, 0); P[1] = pack8(s0, 8); P[2] = pack8(s1, 0); P[3] = pack8(s1, 8);
                LAS unsigned char* pp = pbase + (t & 1) * DP_PSLOT;
#pragma unroll
                for (int q = 0; q < 4; ++q) *(LAS bf16x8*)(pp + q * 1024) = P[q];
                *(LAS float*)(pp + 4 * 1024) = a;
            }
            DP_BAR();
        }
        l = xhalf_sum(l);
        const float inv_l = 1.0f / l;
        *(LAS float*)(pbase + 4 * 1024 + 4) = inv_l;
        DP_BAR();
        int tl = tid; asm volatile("" : "+v"(tl));
        if (DP_NBP == 2) dp_post<2, 0>(O, inv_l, pr, lam, post_scale, park + (size_t)tl * 128, sg, att_head + (size_t)qpos * DM, ssx, tid, hi);
        else if (pr == 1) { ssx[tid] = 0.f; DP_BAR(); DP_BAR(); }
    } else {
        f32x16 O[DP_NBC];
#pragma unroll
        for (int b = 0; b < DP_NBC; ++b)
#pragma unroll
            for (int e = 0; e < 16; ++e) O[b][e] = 0.f;
        u32x4 vreg[8], kreg[4];
        DP_ISSUE_K(0); DP_COMMIT_K(0); DP_ISSUE_K(1); DP_ISSUE_V(0);
        DP_BAR();
        for (int tau = -1; tau < nt; ++tau) {
            asm volatile("" : "+v"(vr), "+v"(vc), "+v"(sr), "+v"(sc16));
            DP_COMMIT_K(tau + 2); DP_COMMIT_V(tau + 1); DP_ISSUE_K(tau + 3); DP_ISSUE_V(tau + 2);
            if (tau >= 0 && 64 * tau <= wqhi) {
                const LAS unsigned char* pp = pbase + (tau & 1) * DP_PSLOT;
                bf16x8 P[4];
#pragma unroll
                for (int q = 0; q < 4; ++q) P[q] = *(const LAS bf16x8*)(pp + q * 1024);
                const float a = *(const LAS float*)(pp + 4 * 1024);
                if (__any(a != 1.0f)) {
#pragma unroll
                    for (int b = 0; b < DP_NBC; ++b)
#pragma unroll
                        for (int e = 0; e < 16; ++e) O[b][e] *= a;
                }
                dp_pv<DP_NBC, DP_NBP>(O, lds + DP_V + (tau & 1) * VB2 + vro, P);
            }
            DP_BAR();
        }
        DP_BAR();
        const float inv_l = *(const LAS float*)(pbase + 4 * 1024 + 4);
        int tl = tid; asm volatile("" : "+v"(tl));
        dp_post<DP_NBC, DP_NBP>(O, inv_l, pr, lam, post_scale, park + (size_t)tl * 128, sg, att_head + (size_t)qpos * DM, ssx, tid, hi);
    }
    DP_BAR();
#undef DP_VOFF
#undef DP_ISSUE_V
#undef DP_COMMIT_V
#undef DP_KOFF
#undef DP_ISSUE_K
#undef DP_COMMIT_K
}
#undef DP_BAR
}

#define XB_TMO      128
#define XB_XCNT(j)  (256  + 64 * (j))
#define XB_XSUB(j)  (1280 + 64 * (j))
#define XB_XGEN(j)  (2304 + 64 * (j))
#define XB_TOP      3328
#define XB_TOPGEN   3392
#define XCD_BAR_WORDS 3456
#define XB_SPIN_CAP (1u << 22)

__device__ __forceinline__ unsigned xb_ld(unsigned* p)              { return __hip_atomic_load(p, __ATOMIC_RELAXED, __HIP_MEMORY_SCOPE_AGENT); }
__device__ __forceinline__ unsigned xb_add(unsigned* p, unsigned v) { return __hip_atomic_fetch_add(p, v, __ATOMIC_RELAXED, __HIP_MEMORY_SCOPE_AGENT); }
__device__ __forceinline__ unsigned xb_xcc_id() { return (unsigned)__builtin_amdgcn_s_getreg((3 << 11) | 20) & 0xFu; }
#define XB_SPIN(cond, bar) do { unsigned _sp = 0; while (cond) { __builtin_amdgcn_s_sleep(1); \
    if ((++_sp & 255u) == 0u) { if (xb_ld(&(bar)[XB_TMO])) break; if (_sp > XB_SPIN_CAP) { atomicAdd(&(bar)[XB_TMO], 1u); break; } } } } while (0)

struct XcdBarrier {
    unsigned* bar; unsigned x;
    volatile LAS unsigned* st;
};

__device__ __forceinline__ XcdBarrier xcd_barrier_post(unsigned* bar, volatile LAS unsigned* st, const bool t0) {
    XcdBarrier b; b.bar = bar; b.x = xb_xcc_id(); b.st = st;
    if (t0) (void)xb_add(&bar[XB_XCNT(b.x)], 1u);
    return b;
}
__device__ __forceinline__ void xcd_barrier_complete(unsigned* bar, unsigned x, unsigned& nloc, unsigned& nx) {
    const unsigned G = gridDim.x * gridDim.y * gridDim.z;
    unsigned sum, cnt, mine, sp = 0u;
    for (;;) {
        sum = 0u; cnt = 0u; mine = 0u;
#pragma unroll
        for (unsigned j = 0; j < 16; ++j) { const unsigned c = xb_ld(&bar[XB_XCNT(j)]); sum += c; cnt += (c > 0u) ? 1u : 0u; mine = (j == x) ? c : mine; }
        if (sum == G) break;
        __builtin_amdgcn_s_sleep(1);
        if ((++sp & 255u) == 0u) { if (xb_ld(&bar[XB_TMO])) break; if (sp > XB_SPIN_CAP) { atomicAdd(&bar[XB_TMO], 1u); break; } }
    }
    nloc = mine > 0u ? mine : 1u; nx = cnt > 0u ? cnt : 1u;
}

__device__ __forceinline__ void xcd_barrier(const XcdBarrier& b, const bool t0) {
    asm volatile("s_waitcnt vmcnt(0)" ::: "memory");
    __syncthreads();
    if (t0) {
        unsigned* bar = b.bar;
        __builtin_amdgcn_s_waitcnt(0);
        unsigned nloc = b.st[0], nx = b.st[1];
        if (nloc == 0u) { xcd_barrier_complete(bar, b.x, nloc, nx); b.st[0] = nloc; b.st[1] = nx; }
        const unsigned old = xb_add(&bar[XB_XSUB(b.x)], 1u);
        const unsigned gen = old / nloc;
        if (old + 1u == (gen + 1u) * nloc) {
            __builtin_amdgcn_fence(__ATOMIC_RELEASE, "agent");
            asm volatile("s_waitcnt vmcnt(0)" ::: "memory");
            const unsigned og = xb_add(&bar[XB_TOP], 1u);
            const unsigned tg = og / nx;
            if (og + 1u == (tg + 1u) * nx) xb_add(&bar[XB_TOPGEN], 1u);
            else XB_SPIN(xb_ld(&bar[XB_TOPGEN]) == tg, bar);
            __builtin_amdgcn_fence(__ATOMIC_ACQUIRE, "agent");
            xb_add(&bar[XB_XGEN(b.x)], 1u);
            asm volatile("s_waitcnt vmcnt(0)" ::: "memory");
        } else {
            XB_SPIN(xb_ld(&bar[XB_XGEN(b.x)]) == gen, bar);
            __builtin_amdgcn_fence(__ATOMIC_ACQUIRE, "agent");
            asm volatile("s_waitcnt vmcnt(0)" ::: "memory");
        }
    }
    __syncthreads();
}

#define AS4 __attribute__((address_space(4)))
#define PHASE_WS() const AS4 unsigned char* ka_ = (const AS4 unsigned char*)__builtin_amdgcn_kernarg_segment_ptr(); asm volatile("" : "+s"(ka_)); unsigned char* ws = *(unsigned char* const AS4*)(ka_ + 152)
#define PIN(i) (*(const float* const AS4*)(ka_ + 8 * (i)))
#define XIN PIN(0)
#define HBUF (*(float* const AS4*)(ka_ + 144))
__global__ void __launch_bounds__(512) fwd_megakernel(Params P) {
    extern __shared__ __attribute__((aligned(16))) unsigned char lds_raw[];
    LAS unsigned char* lds = (LAS unsigned char*)lds_raw;
    cg::grid_group grid = cg::this_grid();
    grid.sync();
    const int G = gridDim.x, bx = blockIdx.x, NGW = G * 8;
    const int wave_s = __builtin_amdgcn_readfirstlane((int)threadIdx.x >> 6);
#define PHASE_IDS() PHASE_WS(); int tid; asm volatile("v_mbcnt_lo_u32_b32 %0, -1, 0\n\tv_mbcnt_hi_u32_b32 %0, -1, %0" : "=v"(tid)); tid += wave_s * 64; const int lane = tid & 63, wave = wave_s, hi = lane >> 5, gw = bx * 8 + wave; (void)hi; (void)gw; (void)lane
    volatile LAS unsigned* xst = (volatile LAS unsigned*)(lds + 152576);
    { int l_; asm volatile("v_mbcnt_lo_u32_b32 %0, -1, 0\n\tv_mbcnt_hi_u32_b32 %0, -1, %0" : "=v"(l_)); if ((l_ + wave_s * 64) < 2) xst[l_] = 0u; }
    __syncthreads();
    XcdBarrier xbar;
    { int l_; asm volatile("v_mbcnt_lo_u32_b32 %0, -1, 0\n\tv_mbcnt_hi_u32_b32 %0, -1, %0" : "=v"(l_)); PHASE_WS(); xbar = xcd_barrier_post((unsigned*)(ws + WS_CTL), xst, (l_ + wave_s * 64) == 0); }
#define XN ((bf16_t*)(ws + WS_XN))
#define BIG ((bf16_t*)(ws + WS_BIG))
#define ATT ((bf16_t*)(ws + WS_ATT))
#define PART ((bf16_t*)(ws + WS_PART))
#define LSE ((float*)(ws + WS_LSE))
#define COS ((float*)(ws + WS_ROPE))
#define SIN (COS + SEQ * 64)
#define KMEAN ((float*)(ws + WS_KMEAN))
    constexpr unsigned long long ROPE_EVEN = 0x000000FFFF00FFFFull;
    constexpr unsigned long long ROPE_ODD = 0x00000000FFFFFFFFull;

    {
        PHASE_IDS();
        LAS float* scr = (LAS float*)(lds + wave * 8448);
#ifndef NO_TRANSP
        for (int rep = 0; rep < REP_PRO; ++rep) {
        for (int l = 0; l < 2; ++l) {
            transpose_items<1>(PIN(2) + (size_t)l * DM * 2 * DFF, DM, 2 * DFF, (bf16_t*)(ws + WS_FFA_IN + l * SZ_WIN), 0, scr, gw, NGW, lane);
            transpose_items<0>(PIN(3) + (size_t)l * DFF * DM, DFF, DM, (bf16_t*)(ws + WS_FFA_OUT + l * SZ_WOUT), 0, scr, gw, NGW, lane);
            transpose_items<1>(PIN(15) + (size_t)l * DM * 2 * DFF, DM, 2 * DFF, (bf16_t*)(ws + WS_FFB_IN + l * SZ_WIN), 0, scr, gw, NGW, lane);
            transpose_items<0>(PIN(16) + (size_t)l * DFF * DM, DFF, DM, (bf16_t*)(ws + WS_FFB_OUT + l * SZ_WOUT), 0, scr, gw, NGW, lane);
        }
        transpose_items<2>(PIN(5), DM, NQKV, (bf16_t*)(ws + WS_MIX_IN), ROPE_EVEN, scr, gw, NGW, lane);
        transpose_items<2>(PIN(7), DM, NQKV, (bf16_t*)(ws + WS_MIX_IN + SZ_WMIN), ROPE_ODD, scr, gw, NGW, lane);
        transpose_items<0>(PIN(6), DM, DM, (bf16_t*)(ws + WS_MIX_OUT), 0, scr, gw, NGW, lane);
        transpose_items<0>(PIN(8), DM, DM, (bf16_t*)(ws + WS_MIX_OUT + SZ_WMOUT), 0, scr, gw, NGW, lane);
        }
#endif
#ifndef NO_ROPETAB
        for (int idx = bx * 512 + tid; idx < SEQ * 64; idx += G * 512) {
            const int pos = idx >> 6, j = idx & 63;
            const float inv = (float)pow(10000.0, -(double)j / 64.0);
            const float ang = (float)pos * inv;
            const double a = (double)ang, n = rint(a * 0.15915494309189535);
            const double r = (a - n * 6.283185307179586) - n * 2.4492935982947064e-16;
            COS[idx] = (float)cos(r); SIN[idx] = (float)sin(r);
        }
#endif
        norm_phase<false>(XIN, PIN(1), XN, gw, NGW, lane);
    }
    GSYNC();

    for (int layer = 0; layer < 2; ++layer) {
        {
            PHASE_WS();
            pg8::Gemm g{XN, (const bf16_t*)(ws + WS_FFA_IN + layer * SZ_WIN), MTOK, 2 * DFF, DM}; pg8::StaticOrder S; { int g_ = G, b_ = bx; asm volatile("" : "+s"(g_), "+s"(b_)); S.init(MTOK, 2 * DFF, g_, b_); }
            pg8::EpiSwiGLU E{BIG, DFF};
#ifndef NO_EPISWIGLU
            for (int rep = 0; rep < REP_SWI; ++rep) pg8::gemm_phase<pg8::EpiSwiGLU, pg8::StaticOrder, true, true>(lds, g, S, E, wave_s);
#endif
        }
        GSYNC();
        {
            PHASE_WS();
            pg8::Gemm g{BIG, (const bf16_t*)(ws + WS_FFA_OUT + layer * SZ_WOUT), MTOK, DM, DFF}; pg8::StaticOrder S; { int g_ = G, b_ = bx; asm volatile("" : "+s"(g_), "+s"(b_)); S.init(MTOK, DM, g_, b_); }
            pg8::EpiResid E{layer == 0 ? XIN : HBUF, HBUF, DM, 0.5f};
#ifndef NO_EPIRESID
            for (int rep = 1; rep < REP_RES; ++rep) { pg8::EpiResid E0 = E; E0.scale = 0.f; pg8::gemm_phase<pg8::EpiResid, pg8::StaticOrder, true, true>(lds, g, S, E0, wave_s); }
            pg8::gemm_phase<pg8::EpiResid, pg8::StaticOrder, true, true>(lds, g, S, E, wave_s);
#endif
        }
        GSYNC();
        { PHASE_IDS(); for (int rep = 0; rep < REP_NORM; ++rep) norm_phase<false>(HBUF, PIN(4) + layer * DM, XN, gw, NGW, lane); }
        GSYNC();
        {
            PHASE_WS();
            pg8::Gemm g{XN, (const bf16_t*)(ws + WS_MIX_IN + layer * SZ_WMIN), MTOK, NQKV, DM}; pg8::StaticOrder S; { int g_ = G, b_ = bx; asm volatile("" : "+s"(g_), "+s"(b_)); S.init(MTOK, NQKV, g_, b_); }
            pg8::EpiQKV E{BIG, NQKV, COS, SIN, layer == 0 ? ROPE_EVEN : ROPE_ODD};
#ifndef NO_EPIQKV
            for (int rep = 0; rep < REP_QKV; ++rep) pg8::gemm_phase<pg8::EpiQKV, pg8::StaticOrder, true, true>(lds, g, S, E, wave_s);
#endif
        }
        GSYNC();
        if (layer == 0) {
            PHASE_IDS();
            for (int rep = 0; rep < REP_DIL; ++rep) {
            for (int it = bx; it < 512; it += G) {
                const int b = it >> 8, h = (it >> 5) & 7, blk = it & 31, c = tid & 127, rg = tid >> 7;
                const bf16_t* kp = BIG + (size_t)(b * SEQ + blk * 256 + rg * 64) * NQKV + 4096 + h * 128 + c;
                float s = 0.f;
                for (int r = 0; r < 64; ++r) s += bf2f(kp[(size_t)r * NQKV]);
                LAS float* red = (LAS float*)lds;
                red[rg * 128 + c] = s; __syncthreads();
                if (tid < 128) KMEAN[(size_t)it * 128 + tid] = (red[tid] + red[128 + tid] + red[256 + tid] + red[384 + tid]) * (1.0f / 256.0f);
                __syncthreads();
            }
#ifndef NO_DIL
            for (int un = bx; un < 1536; un += G) {
                const int u = un & 31, br = (un >> 5) % 3, bh = un / 96, b = bh >> 3, h = bh & 7;
                const int dl = br == 0 ? 1 : (br == 1 ? 4 : 16);
                const int upr = 32 / dl, res = u / upr, ub = u % upr;
                const long row0 = (long)b * SEQ + res;
                const int qlo = 256 * ub + 32 * wave, qpos = qlo + (lane & 31);
                bf16x8 qf[8]; att::load_q(qf, BIG + h * 128, row0 + (long)qpos * dl, hi);
                f32x16 O[4]; float m, l; att::zero_state(O, m, l);
                att::TSDil ts{256 * ub - 128, qlo, qpos};
                att::flash_pass(lds, BIG + 1024 + h * 128, BIG + 2048 + h * 128, row0, dl, qf, ts, O, m, l, tid);
                l = att::xhalf_sum(l);
                const long grow = row0 + (long)qpos * dl;
                att::store_o(O, 1.0f / l, PART + ((size_t)br * MTOK + grow) * 1024 + h * 128, hi);
                if (hi == 0) LSE[((size_t)br * MTOK + grow) * 8 + h] = m + log2f(l);
            }
#endif
            }
        } else {
            PHASE_IDS();
#ifndef NO_DIFF
            const float lam_init = 0.35550906759096927f;
            float d1 = 0.f, d2 = 0.f;
            for (int i = 0; i < 128; ++i) { d1 += PIN(9)[i] * PIN(10)[i]; d2 += PIN(11)[i] * PIN(12)[i]; }
            const float lam = __uint_as_float(__builtin_amdgcn_readfirstlane(__float_as_uint(expf(d1) - expf(d2) + lam_init)));
            float* park = (float*)PART + (size_t)bx * 128 * 512;
            for (int rep = 0; rep < REP_DIFF; ++rep)
            for (int un = bx; un < 1024; un += G) {
                const int j4 = un >> 8, c8 = un & 255, bh = c8 >> 4, x16 = c8 & 15, b = bh >> 3, h = bh & 7;
                const int qb = j4 == 0 ? 63 - x16 : (j4 == 1 ? 32 + x16 : (j4 == 2 ? 31 - x16 : x16));
                const int row0 = b * SEQ;
#pragma unroll 1
                for (int pr = 0; pr < 2; ++pr)
                    att::diff_pass(lds, BIG + 2048 + h * 256 + pr * 128, BIG + 4096 + h * 256, BIG + h * 256 + pr * 128, row0, qb, pr, lam, 1.0f - lam_init, park, PIN(13), ATT + (size_t)row0 * DM + h * 256, tid);
            }
#endif
        }
        GSYNC();
        if (layer == 0) {
            PHASE_IDS();
            for (int rep = 0; rep < REP_MOBA; ++rep) {
            for (int idx = bx * 512 + tid; idx < MTOK * 128; idx += G * 512) {
                const int row = idx >> 7, h = (idx >> 4) & 7, ch = idx & 15;
                float L[3]; u32x4 pv[3];
#pragma unroll
                for (int br = 0; br < 3; ++br) { L[br] = LSE[((size_t)br * MTOK + row) * 8 + h]; pv[br] = *(const u32x4*)(PART + ((size_t)br * MTOK + row) * 1024 + h * 128 + ch * 8); }
                const float mx = fmaxf(L[0], fmaxf(L[1], L[2]));
                float w[3]; float sw = 0.f;
#pragma unroll
                for (int br = 0; br < 3; ++br) { w[br] = __builtin_amdgcn_exp2f(L[br] - mx); sw += w[br]; }
                const float isw = 1.0f / sw;
                float o[8];
#pragma unroll
                for (int i = 0; i < 8; ++i) o[i] = 0.f;
#pragma unroll
                for (int br = 0; br < 3; ++br) { const float wb = w[br] * isw;
#pragma unroll
                    for (int i = 0; i < 4; ++i) { const unsigned wd = pv[br][i]; o[2 * i] += wb * bf2f((unsigned short)(wd & 0xffffu)); o[2 * i + 1] += wb * bf2f((unsigned short)(wd >> 16)); } }
                u32x4 r; r.x = pk2(o[0], o[1]); r.y = pk2(o[2], o[3]); r.z = pk2(o[4], o[5]); r.w = pk2(o[6], o[7]);
                *(u32x4*)(ATT + (size_t)row * DM + h * 128 + ch * 8) = r;
            }
#ifndef NO_MOBA
            LAS float* kmL = (LAS float*)(lds + 77824);
            LAS unsigned* selL = (LAS unsigned*)(lds + 94208);
            LAS unsigned* wmL = (LAS unsigned*)(lds + 95232);
            LAS int* listL = (LAS int*)(lds + 95296);
            for (int un = bx; un < 512; un += G) {
                const int sel = un & 255, bh = sel >> 4, qb = (un < 256) ? 31 - (sel & 15) : (sel & 15), b = bh >> 3, h = bh & 7;
                const long row0 = (long)b * SEQ;
                for (int i = tid; i < qb * 128; i += 512) kmL[i] = KMEAN[(size_t)(bh * 32) * 128 + i];
                __syncthreads();
                {
                    const int q = tid >> 1, part = tid & 1;
                    const bf16_t* qp = BIG + (size_t)(row0 + qb * 256 + q) * NQKV + 3072 + h * 128 + 64 * part;
                    float qv[64];
#pragma unroll
                    for (int c = 0; c < 8; ++c) { const u32x4 w = *(const u32x4*)(qp + 8 * c);
#pragma unroll
                        for (int i = 0; i < 4; ++i) { qv[8 * c + 2 * i] = bf2f((unsigned short)(w[i] & 0xffffu)); qv[8 * c + 2 * i + 1] = bf2f((unsigned short)(w[i] >> 16)); } }
                    float v0 = -3e38f, v1 = -3e38f, v2 = -3e38f; int i0 = -1, i1 = -1, i2 = -1;
                    for (int j = 0; j < qb; ++j) {
                        const LAS float* km = kmL + j * 128 + 64 * part; float d = 0.f;
#pragma unroll
                        for (int i = 0; i < 64; ++i) d += qv[i] * km[i];
                        d += shfl_xor_f(d, 1, lane);
                        if (d > v0) { v2 = v1; i2 = i1; v1 = v0; i1 = i0; v0 = d; i0 = j; }
                        else if (d > v1) { v2 = v1; i2 = i1; v1 = d; i1 = j; }
                        else if (d > v2) { v2 = d; i2 = j; }
                    }
                    unsigned mk = 0u; if (i0 >= 0) mk |= 1u << i0; if (i1 >= 0) mk |= 1u << i1; if (i2 >= 0) mk |= 1u << i2;
                    if (part == 0) selL[q] = mk;
                }
                __syncthreads();
                const unsigned lmask = selL[32 * wave + (lane & 31)];
                unsigned wm = lmask, am = lmask;
#pragma unroll
                for (int o = 1; o < 64; o <<= 1) { wm |= (unsigned)shfl_xor_i((int)wm, o, lane); am &= (unsigned)shfl_xor_i((int)am, o, lane); }
                if (lane == 0) wmL[wave] = wm;
                __syncthreads();
                if (tid == 0) {
                    unsigned U = 0u; for (int w = 0; w < 8; ++w) U |= wmL[w];
                    int n = 0;
                    for (int j = 0; j < qb; ++j) if ((U >> j) & 1u) { for (int i = 0; i < 4; ++i) listL[n++] = 256 * j + 64 * i; }
                    for (int i = 0; i < 4; ++i) listL[n++] = 256 * qb + 64 * i;
                    listL[130] = n;
                }
                __syncthreads();
                const int qlo = 256 * qb + 32 * wave, qpos = qlo + (lane & 31);
                bf16x8 qf[8]; att::load_q(qf, BIG + 3072 + h * 128, row0 + qpos, hi);
                f32x16 O[4]; float m, l; att::zero_state(O, m, l);
                att::TSMoba ts{listL, listL[130], qb, qpos, qlo + 31, wm, lmask, am};
                att::flash_pass(lds, BIG + 4096 + h * 128, BIG + 5120 + h * 128, row0, 1, qf, ts, O, m, l, tid);
                l = att::xhalf_sum(l);
                att::store_o(O, 1.0f / l, ATT + (size_t)(row0 + qpos) * DM + 1024 + h * 128, hi);
                __syncthreads();
            }
#endif
            }
            GSYNC();
        }
        {
            PHASE_WS();
            pg8::Gemm g{ATT, (const bf16_t*)(ws + WS_MIX_OUT + layer * SZ_WMOUT), MTOK, DM, DM}; pg8::StaticOrder S; { int g_ = G, b_ = bx; asm volatile("" : "+s"(g_), "+s"(b_)); S.init(MTOK, DM, g_, b_); }
            pg8::EpiResid E{HBUF, HBUF, DM, 1.0f};
#ifndef NO_EPIRESID
            for (int rep = 1; rep < REP_RES; ++rep) { pg8::EpiResid E0 = E; E0.scale = 0.f; pg8::gemm_phase<pg8::EpiResid, pg8::StaticOrder, true, true>(lds, g, S, E0, wave_s); }
            pg8::gemm_phase<pg8::EpiResid, pg8::StaticOrder, true, true>(lds, g, S, E, wave_s);
#endif
        }
        GSYNC();
        { PHASE_IDS(); for (int rep = 0; rep < REP_NORM; ++rep) norm_phase<false>(HBUF, PIN(14) + layer * DM, XN, gw, NGW, lane); }
        GSYNC();
        {
            PHASE_WS();
            pg8::Gemm g{XN, (const bf16_t*)(ws + WS_FFB_IN + layer * SZ_WIN), MTOK, 2 * DFF, DM}; pg8::StaticOrder S; { int g_ = G, b_ = bx; asm volatile("" : "+s"(g_), "+s"(b_)); S.init(MTOK, 2 * DFF, g_, b_); }
            pg8::EpiSwiGLU E{BIG, DFF};
#ifndef NO_EPISWIGLU
            for (int rep = 0; rep < REP_SWI; ++rep) pg8::gemm_phase<pg8::EpiSwiGLU, pg8::StaticOrder, true, true>(lds, g, S, E, wave_s);
#endif
        }
        GSYNC();
        {
            PHASE_WS();
            pg8::Gemm g{BIG, (const bf16_t*)(ws + WS_FFB_OUT + layer * SZ_WOUT), MTOK, DM, DFF}; pg8::StaticOrder S; { int g_ = G, b_ = bx; asm volatile("" : "+s"(g_), "+s"(b_)); S.init(MTOK, DM, g_, b_); }
            pg8::EpiResid E{HBUF, HBUF, DM, 0.5f};
#ifndef NO_EPIRESID
            for (int rep = 1; rep < REP_RES; ++rep) { pg8::EpiResid E0 = E; E0.scale = 0.f; pg8::gemm_phase<pg8::EpiResid, pg8::StaticOrder, true, true>(lds, g, S, E0, wave_s); }
            pg8::gemm_phase<pg8::EpiResid, pg8::StaticOrder, true, true>(lds, g, S, E, wave_s);
#endif
        }
        GSYNC();
        if (layer == 0) { { PHASE_IDS(); norm_phase<false>(HBUF, PIN(1) + DM, XN, gw, NGW, lane); } GSYNC(); }
        else { PHASE_IDS(); norm_phase<true>(HBUF, PIN(17), HBUF, gw, NGW, lane); }
    }
}

extern "C" void kernel_launch(void* const* d_in, const int* in_sizes, int n_in, void* d_out, int out_size, void* d_ws, size_t ws_size, hipStream_t stream) {
    static int grid_blocks = 0;
    if (grid_blocks == 0) {
        if (n_in != 18 || ws_size < WS_END) { fprintf(stderr, "kernel_launch: need 18 inputs and %zu bytes of workspace; got %d, %zu\n", (size_t)WS_END, n_in, ws_size); grid_blocks = -1; return; }
        int dev = 0, cus = 0, per_cu = 0;
        hipGetDevice(&dev);
        hipDeviceGetAttribute(&cus, hipDeviceAttributeMultiprocessorCount, dev);
        hipFuncSetAttribute((const void*)fwd_megakernel, hipFuncAttributeMaxDynamicSharedMemorySize, LDS_BYTES);
        hipOccupancyMaxActiveBlocksPerMultiprocessor(&per_cu, (const void*)fwd_megakernel, 512, LDS_BYTES);
        if (per_cu < 1) { fprintf(stderr, "kernel_launch: occupancy query says %d blocks per CU\n", per_cu); per_cu = 1; }
        (void)hipGetLastError();
        grid_blocks = cus * per_cu;
    }
    if (grid_blocks < 0) return;
    if (hipMemsetAsync((char*)d_ws + WS_CTL, 0, CTL_BYTES, stream) != hipSuccess) { fprintf(stderr, "kernel_launch: hipMemsetAsync failed\n"); return; }
    Params p{};
    for (int i = 0; i < 18; ++i) p.in[i] = (const float*)d_in[i];
    p.out = (float*)d_out; p.ws = (unsigned char*)d_ws;
    void* args[] = {&p};
    hipError_t e = hipLaunchCooperativeKernel((const void*)fwd_megakernel, dim3(grid_blocks), dim3(512), args, LDS_BYTES, stream);
    if (e != hipSuccess) fprintf(stderr, "cooperative launch failed: %s (grid %d)\n", hipGetErrorString(e), grid_blocks);
}
```

```cpp
#include <hip/hip_runtime.h>
#include <hip/hip_cooperative_groups.h>
#include <cstdio>
#include <cstdint>
namespace cg = cooperative_groups;
namespace pg8 {
#define PG8_LAS __attribute__((address_space(3)))
typedef unsigned short bf16_t;
typedef short bf16x8 __attribute__((ext_vector_type(8)));
typedef float f32x4 __attribute__((ext_vector_type(4)));
typedef unsigned u32x4 __attribute__((ext_vector_type(4)));
constexpr int BM = 256, BK = 64, HALF = 128, HTB = HALF * BK * 2  , STAGE_BYTES = 8 * HTB, NXCD = 8, WGM = 8;

__host__ __device__ __forceinline__ int lds_byte(int r, int c) { const int st = (r >> 4) * 2 + (c >> 5), rr = r & 15, cc = c & 31, ob = rr * 64 + cc * 2; return st * 1024 + (ob ^ (((ob >> 9) & 1) << 5)); }
__host__ __device__ __forceinline__ void stage_rc(int b, int& R, int& C) { const int st = b / 1024, sb = b % 1024, swz = sb ^ (((sb >> 9) & 1) << 5); R = (st >> 1) * 16 + swz / 64; C = (st & 1) * 32 + (swz % 64) / 2; }
__host__ __device__ __forceinline__ int perm32(int rho) { const int n = rho >> 4, i = rho & 15; return 8 * (i >> 2) + 4 * n + (i & 3); }

struct Unit { int pm, pn; };
struct Gemm { const bf16_t* A; const bf16_t* Bt; int M, N, K; };

struct StaticOrder {
    int nM, nN, nwg, G, c;
    __host__ __device__ void init(int M, int N, int G_, int c_) { nM = M / BM; nN = N / BM; nwg = nM * nN; G = G_; c = c_; }
    __host__ __device__ bool next(int i, Unit& u) const {
        const long L = (long)i * G + c; if (L >= nwg) return false;
        int wgid = (int)L; { const int q = nwg / NXCD, r = nwg % NXCD, xcd = wgid % NXCD, off = wgid / NXCD; wgid = (xcd < r ? xcd * (q + 1) : r * (q + 1) + (xcd - r) * q) + off; }
        const int nig = WGM * nN, gid = wgid / nig, fm = gid * WGM, gsz = (nM - fm) < WGM ? (nM - fm) : WGM;
        u.pm = fm + ((wgid % nig) % gsz); u.pn = (wgid % nig) / gsz; return true;
    }
    __device__ __forceinline__ void a_ready(const Unit&) const {}
    __device__ __forceinline__ void done(const Unit&) const {}
};

__device__ __forceinline__ unsigned cvt_pk_bf16(float lo, float hi) { unsigned r; asm volatile("v_cvt_pk_bf16_f32 %0, %1, %2" : "=v"(r) : "v"(lo), "v"(hi)); return r; }
typedef float f32x2 __attribute__((ext_vector_type(2)));
struct EpiSwiGLU {
    static constexpr bool PERM = true, AFTER_DRAIN = false;
    bf16_t* O; int ldc;
    __device__ __forceinline__ void operator()(const f32x4 (&acc)[2][2][4][2], const Unit& u, int wr, int wc, int fr, int fq) const {
        const int row0 = u.pm * BM + wr * 64 + fr, col0 = u.pn * HALF + wc * 32 + 8 * fq;
#pragma unroll
        for (int ai = 0; ai < 2; ++ai)
#pragma unroll
            for (int m = 0; m < 4; ++m) {
                bf16_t* rowp = O + (size_t)(row0 + ai * HALF + m * 16) * ldc + col0;
                float h[8];
#pragma unroll
                for (int n = 0; n < 2; ++n)
#pragma unroll
                    for (int e = 0; e < 4; ++e) { const float g = acc[ai][0][m][n][e], up = acc[ai][1][m][n][e];
                        const float sg = __builtin_amdgcn_rcpf(1.0f + __builtin_amdgcn_exp2f(-1.4426950408889634f * g)); h[n * 4 + e] = g * sg * up; }
                u32x4 w; w.x = cvt_pk_bf16(h[0], h[1]); w.y = cvt_pk_bf16(h[2], h[3]); w.z = cvt_pk_bf16(h[4], h[5]); w.w = cvt_pk_bf16(h[6], h[7]);
                *(u32x4*)rowp = w;
            }
    }
};
struct EpiResid {
    static constexpr bool PERM = true, AFTER_DRAIN = false;
    const float* base; float* out; int ldc; float scale;
    __device__ __forceinline__ void operator()(const f32x4 (&acc)[2][2][4][2], const Unit& u, int wr, int wc, int fr, int fq) const {
        const int row0 = u.pm * BM + wr * 64 + fr, col0 = u.pn * BM + wc * 32 + 8 * fq;
#pragma unroll
        for (int ai = 0; ai < 2; ++ai)
#pragma unroll
            for (int m = 0; m < 4; ++m)
#pragma unroll
                for (int bj = 0; bj < 2; ++bj) {
                    const size_t p = (size_t)(row0 + ai * HALF + m * 16) * ldc + col0 + bj * HALF;
                    const f32x4 b0 = *(const f32x4*)(base + p), b1 = *(const f32x4*)(base + p + 4);
                    *(f32x4*)(out + p) = b0 + acc[ai][bj][m][0] * scale; *(f32x4*)(out + p + 4) = b1 + acc[ai][bj][m][1] * scale;
                }
    }
};
struct EpiQKV {
    static constexpr bool PERM = true, AFTER_DRAIN = false;
    bf16_t* O; int ldc; const float* cosT; const float* sinT; unsigned long long ropemask;
    __device__ __forceinline__ void operator()(const f32x4 (&acc)[2][2][4][2], const Unit& u, int wr, int wc, int fr, int fq) const {
        const int row0 = u.pm * BM + wr * 64 + fr, col0 = u.pn * BM + wc * 32 + 8 * fq, j0 = 16 * wc + 4 * fq;
#pragma unroll
        for (int ai = 0; ai < 2; ++ai)
#pragma unroll
            for (int m = 0; m < 4; ++m) {
                const int row = row0 + ai * HALF + m * 16, pos = row & 8191;
                const f32x4 cs = *(const f32x4*)(cosT + pos * 64 + j0), sn = *(const f32x4*)(sinT + pos * 64 + j0);
#pragma unroll
                for (int bj = 0; bj < 2; ++bj) {
                    const bool roped = (ropemask >> (u.pn * 2 + bj)) & 1ull;
                    f32x4 v0 = acc[ai][bj][m][0], v1 = acc[ai][bj][m][1];
                    if (roped) {
                        const f32x4 a = v0, b = v1;
                        v0[0] = a[0] * cs[0] - a[1] * sn[0]; v0[1] = a[1] * cs[0] + a[0] * sn[0];
                        v0[2] = a[2] * cs[1] - a[3] * sn[1]; v0[3] = a[3] * cs[1] + a[2] * sn[1];
                        v1[0] = b[0] * cs[2] - b[1] * sn[2]; v1[1] = b[1] * cs[2] + b[0] * sn[2];
                        v1[2] = b[2] * cs[3] - b[3] * sn[3]; v1[3] = b[3] * cs[3] + b[2] * sn[3];
                    }
                    u32x4 w; w.x = cvt_pk_bf16(v0[0], v0[1]); w.y = cvt_pk_bf16(v0[2], v0[3]); w.z = cvt_pk_bf16(v1[0], v1[1]); w.w = cvt_pk_bf16(v1[2], v1[3]);
                    *(u32x4*)(O + (size_t)row * ldc + col0 + bj * HALF) = w;
                }
            }
    }
};
template <class Epi, class Sched, bool ALIGN_EPI = false, bool SP2 = false>
__device__ __forceinline__ void gemm_phase(PG8_LAS unsigned char* lds, const Gemm g, const Sched& S, const Epi& E, const int wave_s  ) {
    int tid_; asm volatile("v_mbcnt_lo_u32_b32 %0, -1, 0\n\tv_mbcnt_hi_u32_b32 %0, -1, %0" : "=v"(tid_)); tid_ += wave_s * 64;
    const int tid = tid_, wid = __builtin_amdgcn_readfirstlane(tid >> 6), lane = tid & 63, wr = wid >> 2, wc = wid & 3, fr = lane & 15, fq = lane >> 4;
    const int K = g.K, nt = K / BK;
    unsigned voffA[2], voffB[2];
#pragma unroll
    for (int i = 0; i < 2; ++i) { int R, C; stage_rc(tid * 16 + i * 8192, R, C); const int Rb = Epi::PERM ? ((R & ~31) + perm32(R & 31)) : R;
        voffA[i] = (unsigned)(R * K + C) * 2u; voffB[i] = (unsigned)(Rb * K + C) * 2u; }
    const size_t kstep = (size_t)(BK * 2);
    const size_t hstep = (size_t)HALF * K * 2;
    const size_t tstep = 2 * hstep;
    const unsigned ldsw = (unsigned)wid * 1024u;
    const int aoff = lds_byte(wr * 64 + fr, fq * 8), boff = lds_byte(wc * 32 + fr, fq * 8);
#define PG8_SA(b, h) (((b) * 2 + (h)) * HTB)
#define PG8_SB(b, h) ((4 + (b) * 2 + (h)) * HTB)
#define PG8_STAGE(bufoff, gbase, voff) do { _Pragma("unroll") for (int _i = 0; _i < 2; ++_i) \
        __builtin_amdgcn_global_load_lds((const unsigned*)((const char*)(gbase) + (voff)[_i]), (PG8_LAS unsigned*)(lds + (bufoff) + ldsw + _i * 8192), 16, 0, 0); } while (0)
#define PG8_LDA(dst, b, h) do { _Pragma("unroll") for (int m = 0; m < 4; ++m) _Pragma("unroll") for (int k = 0; k < 2; ++k) dst[m][k] = *(const PG8_LAS bf16x8*)(lds + PG8_SA(b, h) + aoff + m * 2048 + k * 1024); } while (0)
#define PG8_LDB(dst, b, h) do { _Pragma("unroll") for (int n = 0; n < 2; ++n) _Pragma("unroll") for (int k = 0; k < 2; ++k) dst[n][k] = *(const PG8_LAS bf16x8*)(lds + PG8_SB(b, h) + boff + n * 2048 + k * 1024); } while (0)
#define PG8_MMA(ai, bj, At, Bt) do { __builtin_amdgcn_s_setprio(1); _Pragma("unroll") for (int m = 0; m < 4; ++m) _Pragma("unroll") for (int n = 0; n < 2; ++n) _Pragma("unroll") for (int k = 0; k < 2; ++k) \
        acc[ai][bj][m][n] = __builtin_amdgcn_mfma_f32_16x16x32_bf16(Bt[n][k], At[m][k], acc[ai][bj][m][n], 0, 0, 0); __builtin_amdgcn_s_setprio(0); } while (0)
#define PG8_WAIT_V(n) asm volatile("s_waitcnt vmcnt(" #n ")" ::: "memory")
#define PG8_WAIT_L(n) asm volatile("s_waitcnt lgkmcnt(" #n ")" ::: "memory")
#define PG8_BAR __builtin_amdgcn_s_barrier()
#define PG8_SCHED __builtin_amdgcn_sched_barrier(0)
    Unit cur, nxt; int ui = 0;
    if (!S.next(0, cur)) return;
    f32x4 acc[2][2][4][2];
#pragma unroll
    for (int a = 0; a < 2; ++a)
#pragma unroll
        for (int b = 0; b < 2; ++b)
#pragma unroll
            for (int m = 0; m < 4; ++m)
#pragma unroll
                for (int n = 0; n < 2; ++n) acc[a][b][m][n] = (f32x4){0.f, 0.f, 0.f, 0.f};
    bf16x8 At[4][2], B0[2][2], B1[2][2];
    const char* cA = (const char*)g.A + (size_t)cur.pm * tstep; const char* cB = (const char*)g.Bt + (size_t)cur.pn * tstep;
    S.a_ready(cur);
    if constexpr (SP2) {
        PG8_STAGE(PG8_SB(0, 0), cB, voffB); PG8_STAGE(PG8_SB(0, 1), cB + hstep, voffB); PG8_STAGE(PG8_SA(0, 0), cA, voffA); PG8_STAGE(PG8_SA(0, 1), cA + hstep, voffA);
        if (wr == 1) PG8_BAR;
        PG8_WAIT_V(2); PG8_BAR;
        PG8_STAGE(PG8_SB(1, 0), cB + kstep, voffB); PG8_STAGE(PG8_SA(1, 0), cA + kstep, voffA); PG8_STAGE(PG8_SB(1, 1), cB + hstep + kstep, voffB);
        PG8_WAIT_V(6); PG8_BAR;
    } else {
        PG8_STAGE(PG8_SB(0, 0), cB, voffB); PG8_STAGE(PG8_SA(0, 0), cA, voffA); PG8_STAGE(PG8_SB(0, 1), cB + hstep, voffB); PG8_STAGE(PG8_SA(0, 1), cA + hstep, voffA);
        if (wr == 1) PG8_BAR;
        PG8_WAIT_V(4); PG8_BAR;
        PG8_STAGE(PG8_SB(1, 0), cB + kstep, voffB); PG8_STAGE(PG8_SA(1, 0), cA + kstep, voffA); PG8_STAGE(PG8_SB(1, 1), cB + hstep + kstep, voffB);
        PG8_WAIT_V(6); PG8_BAR;
    }
    for (;;) {
        const bool has_next = S.next(ui + 1, nxt);
        const char* nA = has_next ? (const char*)g.A + (size_t)nxt.pm * tstep : cA; const char* nB = has_next ? (const char*)g.Bt + (size_t)nxt.pn * tstep : cB;
        for (int t = 0; t < nt; t += 2) {
            const bool last = (t == nt - 2);
            const char* a1 = cA + (size_t)(t + 1) * kstep;
            const char* a2 = last ? nA : cA + (size_t)(t + 2) * kstep; const char* b2 = last ? nB : cB + (size_t)(t + 2) * kstep;
            const char* a3 = a2 + kstep; const char* b3 = b2 + kstep;
            if (last && has_next) S.a_ready(nxt);
            if constexpr (SP2) {
            PG8_LDB(B0, 0, 0); PG8_LDB(B1, 0, 1); PG8_SCHED; PG8_LDA(At, 0, 0); PG8_STAGE(PG8_SA(1, 1), a1 + hstep, voffA);
            PG8_WAIT_V(8); PG8_WAIT_L(0); PG8_BAR; PG8_MMA(0, 0, At, B0); PG8_MMA(0, 1, At, B1); PG8_BAR; PG8_SCHED;
            PG8_LDA(At, 0, 1); PG8_STAGE(PG8_SB(0, 0), b2, voffB); PG8_STAGE(PG8_SB(0, 1), b2 + hstep, voffB); PG8_STAGE(PG8_SA(0, 0), a2, voffA);
            PG8_WAIT_V(8); PG8_WAIT_L(0); PG8_BAR; PG8_MMA(1, 0, At, B0); PG8_MMA(1, 1, At, B1); PG8_BAR; PG8_SCHED;
            PG8_LDB(B0, 1, 0); PG8_LDB(B1, 1, 1); PG8_SCHED; PG8_LDA(At, 1, 0); PG8_STAGE(PG8_SA(0, 1), a2 + hstep, voffA);
            PG8_WAIT_V(8); PG8_WAIT_L(0); PG8_BAR; PG8_MMA(0, 0, At, B0); PG8_MMA(0, 1, At, B1); PG8_BAR; PG8_SCHED;
            PG8_LDA(At, 1, 1); PG8_STAGE(PG8_SB(1, 0), b3, voffB); PG8_STAGE(PG8_SB(1, 1), b3 + hstep, voffB); PG8_STAGE(PG8_SA(1, 0), a3, voffA);
            PG8_WAIT_V(8); PG8_WAIT_L(0); PG8_BAR; PG8_MMA(1, 0, At, B0); PG8_MMA(1, 1, At, B1); PG8_BAR; PG8_SCHED;
            } else {
            PG8_LDB(B0, 0, 0); PG8_SCHED; PG8_LDA(At, 0, 0); PG8_STAGE(PG8_SA(1, 1), a1 + hstep, voffA);
            PG8_WAIT_L(8); PG8_BAR; PG8_WAIT_L(0); PG8_MMA(0, 0, At, B0); PG8_BAR; PG8_SCHED;
            PG8_LDB(B1, 0, 1); PG8_STAGE(PG8_SB(0, 0), b2, voffB);
            PG8_BAR; PG8_WAIT_L(0); PG8_MMA(0, 1, At, B1); PG8_BAR;
            PG8_LDA(At, 0, 1); PG8_STAGE(PG8_SA(0, 0), a2, voffA);
            PG8_BAR; PG8_WAIT_L(0); PG8_MMA(1, 0, At, B0); PG8_BAR; PG8_SCHED;
            PG8_STAGE(PG8_SB(0, 1), b2 + hstep, voffB);
            PG8_WAIT_V(6); PG8_BAR; PG8_MMA(1, 1, At, B1); PG8_BAR;
            PG8_LDB(B0, 1, 0); PG8_SCHED; PG8_LDA(At, 1, 0); PG8_STAGE(PG8_SA(0, 1), a2 + hstep, voffA);
            PG8_WAIT_L(8); PG8_BAR; PG8_WAIT_L(0); PG8_MMA(0, 0, At, B0); PG8_BAR; PG8_SCHED;
            PG8_LDB(B1, 1, 1); PG8_STAGE(PG8_SB(1, 0), b3, voffB);
            PG8_BAR; PG8_WAIT_L(0); PG8_MMA(0, 1, At, B1); PG8_BAR;
            PG8_LDA(At, 1, 1); PG8_STAGE(PG8_SA(1, 0), a3, voffA);
            PG8_BAR; PG8_WAIT_L(0); PG8_MMA(1, 0, At, B0); PG8_BAR; PG8_SCHED;
            PG8_STAGE(PG8_SB(1, 1), b3 + hstep, voffB);
            PG8_WAIT_V(6); PG8_BAR; PG8_MMA(1, 1, At, B1); PG8_BAR;
            }
        }
        if constexpr (ALIGN_EPI) { if (wr == 0) PG8_BAR; }
        if constexpr (!Epi::AFTER_DRAIN) { E(acc, cur, wr, wc, fr, fq); S.done(cur); }
        if (!has_next) break;
#pragma unroll
        for (int a = 0; a < 2; ++a)
#pragma unroll
            for (int b = 0; b < 2; ++b)
#pragma unroll
                for (int m = 0; m < 4; ++m)
#pragma unroll
                    for (int n = 0; n < 2; ++n) acc[a][b][m][n] = (f32x4){0.f, 0.f, 0.f, 0.f};
        cur = nxt; cA = nA; cB = nB; ++ui;
        if constexpr (ALIGN_EPI) { if (wr == 1) PG8_BAR; }
    }
    PG8_WAIT_V(0);
    if constexpr (!ALIGN_EPI) { if (wr == 0) PG8_BAR; }
    PG8_BAR;
    if constexpr (Epi::AFTER_DRAIN) { E.fused(acc, cur, wr, wc, fr, fq, lds, wid, lane); S.done(cur); }
#undef PG8_SA
#undef PG8_SB
#undef PG8_STAGE
#undef PG8_LDA
#undef PG8_LDB
#undef PG8_MMA
#undef PG8_WAIT_V
#undef PG8_WAIT_L
#undef PG8_BAR
#undef PG8_SCHED
}
}

#define LAS __attribute__((address_space(3)))
typedef unsigned short bf16_t;
typedef short bf16x8 __attribute__((ext_vector_type(8)));
typedef short s16x4 __attribute__((ext_vector_type(4)));
typedef float f32x4 __attribute__((ext_vector_type(4)));
typedef float f32x16 __attribute__((ext_vector_type(16)));
typedef unsigned u32x4 __attribute__((ext_vector_type(4)));
typedef unsigned u32x2 __attribute__((ext_vector_type(2)));

constexpr int SEQ = 8192, DM = 2048, MTOK = 16384, DFF = 5632, NQKV = 6144, HD = 128;
constexpr size_t SZ_WIN = (size_t)2 * DFF * DM * 2, SZ_WOUT = (size_t)DM * DFF * 2, SZ_WMIN = (size_t)NQKV * DM * 2, SZ_WMOUT = (size_t)DM * DM * 2;
constexpr size_t WS_FFA_IN = 0, WS_FFA_OUT = WS_FFA_IN + 2 * SZ_WIN, WS_FFB_IN = WS_FFA_OUT + 2 * SZ_WOUT, WS_FFB_OUT = WS_FFB_IN + 2 * SZ_WIN;
constexpr size_t WS_MIX_IN = WS_FFB_OUT + 2 * SZ_WOUT, WS_MIX_OUT = WS_MIX_IN + 2 * SZ_WMIN;
constexpr size_t WS_XN = WS_MIX_OUT + 2 * SZ_WMOUT;
constexpr size_t WS_BIG = WS_XN + (size_t)MTOK * DM * 2;
constexpr size_t WS_ATT = WS_BIG + (size_t)MTOK * NQKV * 2;
constexpr size_t WS_PART = WS_ATT + (size_t)MTOK * DM * 2;
constexpr size_t WS_LSE = WS_PART + (size_t)3 * MTOK * 1024 * 2;
constexpr size_t WS_ROPE = WS_LSE + (size_t)3 * MTOK * 8 * 4;
constexpr size_t WS_KMEAN = WS_ROPE + (size_t)2 * SEQ * 64 * 4;
constexpr size_t WS_CTL = WS_KMEAN + (size_t)2 * 8 * 32 * 128 * 4, CTL_BYTES = 16384;
constexpr size_t WS_END = WS_CTL + CTL_BYTES;

#ifndef REP_ATT
#define REP_ATT 1
#endif
#ifndef REP_DIL
#define REP_DIL REP_ATT
#endif
#ifndef REP_MOBA
#define REP_MOBA REP_ATT
#endif
#ifndef REP_DIFF
#define REP_DIFF REP_ATT
#endif
#ifndef REP_PRO
#define REP_PRO 1
#endif
#ifndef REP_SWI
#define REP_SWI 1
#endif
#ifndef REP_QKV
#define REP_QKV 1
#endif
#ifndef REP_NORM
#define REP_NORM 1
#endif
#ifndef REP_RES
#define REP_RES 1
#endif
#ifndef REP_SYNC
#define REP_SYNC 1
#endif
#define GSYNC() do { for (int rs_ = 0; rs_ < REP_SYNC; ++rs_) { int l_; asm volatile("v_mbcnt_lo_u32_b32 %0, -1, 0\n\tv_mbcnt_hi_u32_b32 %0, -1, %0" : "=v"(l_)); xcd_barrier(xbar, (l_ + wave_s * 64) == 0); } } while (0)
constexpr int LDS_BYTES = 153600;

struct Params {
    const float* in[18];
    float* out; unsigned char* ws;
};

__device__ __forceinline__ unsigned f2bf(float f) { unsigned u = __builtin_bit_cast(unsigned, f); return (u + 0x7fffu + ((u >> 16) & 1u)) >> 16; }
__device__ __forceinline__ unsigned pk2(float lo, float hi) { return f2bf(lo) | (f2bf(hi) << 16); }
__device__ __forceinline__ float bf2f(unsigned short b) { return __builtin_bit_cast(float, (unsigned)b << 16); }
__device__ __forceinline__ int shfl_xor_i(int v, int o, int lane) { return __builtin_amdgcn_ds_bpermute((lane ^ o) << 2, v); }
__device__ __forceinline__ float shfl_xor_f(float v, int o, int lane) { return __int_as_float(__builtin_amdgcn_ds_bpermute((lane ^ o) << 2, __float_as_int(v))); }
__device__ __forceinline__ float wave_sum(float v, int lane) {
#pragma unroll
    for (int o = 1; o < 64; o <<= 1) v += shfl_xor_f(v, o, lane);
    return v;
}

template <int MODE>
__device__ __forceinline__ int src_col(int n, unsigned long long ropemask) {
    if (MODE == 0) return n;
    if (MODE == 1) { const int pn = n >> 8, cc = n & 255; return cc < 128 ? pn * 128 + cc : DFF + pn * 128 + (cc - 128); }
    const int hg = n >> 7, p = n & 127;
    if ((ropemask >> hg) & 1ull) return hg * 128 + ((p & 1) ? 64 + (p >> 1) : (p >> 1));
    return n;
}
template <int MODE>
__device__ __forceinline__ void transpose_items(const float* W, int K, int N, bf16_t* WT, unsigned long long ropemask, LAS float* scr, int gw, int NGW, int lane) {
    const int nblk = N / 32, nitems = (K / 64) * nblk;
    for (int item = gw; item < nitems; item += NGW) {
        const int kb = item / nblk, nb = item % nblk, k0 = 64 * kb, n0 = 32 * nb;
        const int sc = src_col<MODE>(n0 + (lane & 31), ropemask);
#pragma unroll
        for (int i = 0; i < 32; ++i) { const int kk = 2 * i + (lane >> 5); scr[kk * 33 + (lane & 31)] = __builtin_nontemporal_load(&W[(size_t)(k0 + kk) * N + sc]); }
        asm volatile("s_waitcnt lgkmcnt(0)" ::: "memory");
        const int c = lane & 7;
#pragma unroll
        for (int j = 0; j < 4; ++j) { const int n = (lane >> 3) + 8 * j; const LAS float* s = scr + (8 * c) * 33 + n;
            u32x4 o; o.x = pk2(s[0 * 33], s[1 * 33]); o.y = pk2(s[2 * 33], s[3 * 33]); o.z = pk2(s[4 * 33], s[5 * 33]); o.w = pk2(s[6 * 33], s[7 * 33]);
            *(u32x4*)(WT + (size_t)(n0 + n) * K + k0 + 8 * c) = o; }
        asm volatile("s_waitcnt lgkmcnt(0)" ::: "memory");
    }
}

template <bool OUT_F32>
__device__ __forceinline__ void norm_phase(const float* src, const float* gain, void* dst, int gw, int NGW, int lane) {
    f32x4 g[8];
#pragma unroll
    for (int j = 0; j < 8; ++j) g[j] = ((const f32x4*)gain)[lane + 64 * j];
    for (int row = gw; row < MTOK; row += 2 * NGW) {
        const f32x4* xr0 = (const f32x4*)(src + (size_t)row * DM) + lane;
        const int rowb = (row + NGW < MTOK) ? row + NGW : row;
        const f32x4* xr1 = (const f32x4*)(src + (size_t)rowb * DM) + lane;
        f32x4 v0[8], v1[8]; float s0 = 0.f, s1 = 0.f;
#pragma unroll
        for (int j = 0; j < 8; ++j) { v0[j] = xr0[64 * j]; v1[j] = xr1[64 * j]; }
#pragma unroll
        for (int j = 0; j < 8; ++j) { s0 += (v0[j].x * v0[j].x + v0[j].y * v0[j].y) + (v0[j].z * v0[j].z + v0[j].w * v0[j].w); s1 += (v1[j].x * v1[j].x + v1[j].y * v1[j].y) + (v1[j].z * v1[j].z + v1[j].w * v1[j].w); }
        const float r0 = 1.0f / sqrtf(wave_sum(s0, lane) * (1.0f / DM) + 1e-6f), r1 = 1.0f / sqrtf(wave_sum(s1, lane) * (1.0f / DM) + 1e-6f);
        if (OUT_F32) { f32x4* o0 = (f32x4*)((float*)dst + (size_t)row * DM) + lane; f32x4* o1 = (f32x4*)((float*)dst + (size_t)rowb * DM) + lane;
#pragma unroll
            for (int j = 0; j < 8; ++j) { o0[64 * j] = v0[j] * r0 * g[j]; o1[64 * j] = v1[j] * r1 * g[j]; }
        } else { u32x2* o0 = (u32x2*)((bf16_t*)dst + (size_t)row * DM) + lane; u32x2* o1 = (u32x2*)((bf16_t*)dst + (size_t)rowb * DM) + lane;
#pragma unroll
            for (int j = 0; j < 8; ++j) { const f32x4 y0 = v0[j] * r0 * g[j], y1 = v1[j] * r1 * g[j]; u32x2 w0, w1; w0.x = pk2(y0.x, y0.y); w0.y = pk2(y0.z, y0.w); w1.x = pk2(y1.x, y1.y); w1.y = pk2(y1.z, y1.w); o0[64 * j] = w0; o1[64 * j] = w1; } }
    }
}

namespace att {
constexpr int KSTR = 272, VSTR = 320, KBYTES = 64 * KSTR, VBYTES = 64 * VSTR;
constexpr float SC = 0.08838834764831845f * 1.4426950408889634f;
constexpr float NEG = -1e30f;
constexpr float NEGR = -1e6f;
__device__ __forceinline__ int crow(int e, int hi) { return (e & 3) + 8 * (e >> 2) + 4 * hi; }
typedef float f32x2_t __attribute__((ext_vector_type(2))); typedef __bf16 bf16x2_t __attribute__((ext_vector_type(2)));
__device__ __forceinline__ unsigned cvtpk(float lo, float hi) { f32x2_t v = {lo, hi}; bf16x2_t b = __builtin_convertvector(v, bf16x2_t); return __builtin_bit_cast(unsigned, b); }
__device__ __forceinline__ float xhalf_max(float v) { auto rr = __builtin_amdgcn_permlane32_swap(__float_as_uint(v), __float_as_uint(v), false, false); return fmaxf(__uint_as_float(rr[0]), __uint_as_float(rr[1])); }
__device__ __forceinline__ float xhalf_sum(float v) { auto rr = __builtin_amdgcn_permlane32_swap(__float_as_uint(v), __float_as_uint(v), false, false); return __uint_as_float(rr[0]) + __uint_as_float(rr[1]); }
__device__ __forceinline__ float max3f(float a, float b, float c) { float r; asm("v_max3_f32 %0, %1, %2, %3" : "=v"(r) : "v"(a), "v"(b), "v"(c)); return r; }
__device__ __forceinline__ float max2f(float a, float b) { float r; asm("v_max_f32_e32 %0, %1, %2" : "=v"(r) : "v"(a), "v"(b)); return r; }
__device__ __forceinline__ float fadd_s(float a, float b) { float r; asm("v_add_f32_e32 %0, %1, %2" : "=v"(r) : "v"(a), "v"(b)); return r; }
__device__ __forceinline__ bf16x8 pack8(const f32x16& s, int o) {
    u32x4 w; w.x = cvtpk(s[o + 0], s[o + 1]); w.y = cvtpk(s[o + 2], s[o + 3]); w.z = cvtpk(s[o + 4], s[o + 5]); w.w = cvtpk(s[o + 6], s[o + 7]);
    return __builtin_bit_cast(bf16x8, w);
}
__device__ __forceinline__ s16x4 vtr(const LAS unsigned char* p) { return __builtin_bit_cast(s16x4, __builtin_amdgcn_ds_read_tr16_b64_v4i16((LAS s16x4*)p)); }

__device__ __forceinline__ void load_q(bf16x8 (&qf)[8], const bf16_t* Qp, long qrow, int hi) {
    const bf16_t* p = Qp + qrow * NQKV + 8 * hi;
#pragma unroll
    for (int c = 0; c < 8; ++c) qf[c] = *(const bf16x8*)(p + 16 * c);
}

#ifndef PF_AHEAD
#define PF_AHEAD 3
#endif
struct Stage { u32x4 kreg[2], vreg[2]; };
template <class TS>
__device__ __forceinline__ void m_block(LAS unsigned char* lds, const TS& ts, int tau, int nt, const bf16x8 (&qf)[8], f32x16 (&O)[4], f32x16& s0, f32x16& s1, const bf16x8 (&P)[4], int kro, int vro) {
#pragma unroll
    for (int e = 0; e < 16; ++e) { s0[e] = 0.f; s1[e] = 0.f; }
#ifdef PROBE_MFMA2
    f32x16 dmy;
#pragma unroll
    for (int e = 0; e < 16; ++e) dmy[e] = 0.f;
#endif
    const bool qk_on = tau + 1 < nt && ts.active(tau + 1);
    const LAS unsigned char* kb = lds + ((tau + 1) & 1) * KBYTES + kro;
    bf16x8 fk[2][4];
    if (qk_on) {
#pragma unroll
        for (int j = 0; j < 2; ++j) { fk[0][2 * j] = *(const LAS bf16x8*)(kb + j * 32); fk[0][2 * j + 1] = *(const LAS bf16x8*)(kb + 32 * KSTR + j * 32); }
    }
    __builtin_amdgcn_sched_barrier(0);
    if (tau >= 0 && ts.active(tau)) {
        const LAS unsigned char* vb = lds + 2 * KBYTES + (tau & 1) * VBYTES + vro;
        s16x4 fl[2][4], fh[2][4];
#pragma unroll
        for (int b = 0; b < 4; ++b) { fl[0][b] = vtr(vb + b * 64); fh[0][b] = vtr(vb + 8 * VSTR + b * 64); }
        __builtin_amdgcn_sched_barrier(0);
#pragma unroll
        for (int q = 0; q < 4; ++q) {
            if (q < 3) {
#pragma unroll
                for (int b = 0; b < 4; ++b) { fl[(q + 1) & 1][b] = vtr(vb + (16 * (q + 1)) * VSTR + b * 64); fh[(q + 1) & 1][b] = vtr(vb + (16 * (q + 1) + 8) * VSTR + b * 64); }
            }
#pragma unroll
            for (int b = 0; b < 4; ++b) {
                const s16x4 lo = fl[q & 1][b], hh = fh[q & 1][b];
                const bf16x8 vf = (bf16x8){lo[0], lo[1], lo[2], lo[3], hh[0], hh[1], hh[2], hh[3]};
                O[b] = __builtin_amdgcn_mfma_f32_32x32x16_bf16(vf, P[q], O[b], 0, 0, 0);
#ifdef PROBE_MFMA2
                dmy = __builtin_amdgcn_mfma_f32_32x32x16_bf16(vf, P[q], dmy, 0, 0, 0);
#endif
            }
            __builtin_amdgcn_sched_barrier(0);
        }
    }
    if (qk_on) {
#pragma unroll
        for (int c2 = 0; c2 < 4; ++c2) {
            if (c2 < 3) {
#pragma unroll
                for (int j = 0; j < 2; ++j) { fk[(c2 + 1) & 1][2 * j] = *(const LAS bf16x8*)(kb + (2 * (c2 + 1) + j) * 32); fk[(c2 + 1) & 1][2 * j + 1] = *(const LAS bf16x8*)(kb + 32 * KSTR + (2 * (c2 + 1) + j) * 32); }
            }
#pragma unroll
            for (int j = 0; j < 2; ++j) {
                s0 = __builtin_amdgcn_mfma_f32_32x32x16_bf16(fk[c2 & 1][2 * j], qf[2 * c2 + j], s0, 0, 0, 0);
                s1 = __builtin_amdgcn_mfma_f32_32x32x16_bf16(fk[c2 & 1][2 * j + 1], qf[2 * c2 + j], s1, 0, 0, 0);
#ifdef PROBE_MFMA2
                dmy = __builtin_amdgcn_mfma_f32_32x32x16_bf16(fk[c2 & 1][2 * j], qf[2 * c2 + j], dmy, 0, 0, 0);
                dmy = __builtin_amdgcn_mfma_f32_32x32x16_bf16(fk[c2 & 1][2 * j + 1], qf[2 * c2 + j], dmy, 0, 0, 0);
#endif
            }
            __builtin_amdgcn_sched_barrier(0);
        }
    }
#ifdef PROBE_MFMA2
    asm volatile("" :: "v"(dmy));
#endif
}
template <class TS>
__device__ __forceinline__ void v_block(LAS unsigned char* lds, const TS& ts, int tau, int ct, int nt, const bf16_t* Kp, const bf16_t* Vp, long krow0, int kstride, Stage& st,
                                        f32x16 (&O)[4], f32x16& s0, f32x16& s1, bf16x8 (&P)[4], float& m, float& l, int sr, int sc16, int hi) {
    asm volatile("" : "+v"(sr), "+v"(sc16));
#define ATT_ROW(t_, i_) ({ int kp_ = ts.kstart(t_) + sr + 32 * (i_); if (TS::CLAMP) kp_ = kp_ < 0 ? 0 : kp_; ((unsigned)((int)krow0 + kp_ * kstride) * (unsigned)NQKV + (unsigned)(sc16 * 8)) * 2u; })
#define ATT_ISSUE_K(t_) do { if ((t_) >= 0 && (t_) < nt) { _Pragma("unroll") for (int i_ = 0; i_ < 2; ++i_) st.kreg[i_] = *(const u32x4*)((const char*)Kp + ATT_ROW(t_, i_)); } } while (0)
#define ATT_ISSUE_V(t_) do { if ((t_) >= 0 && (t_) < nt) { _Pragma("unroll") for (int i_ = 0; i_ < 2; ++i_) st.vreg[i_] = *(const u32x4*)((const char*)Vp + ATT_ROW(t_, i_)); } } while (0)
#define ATT_COMMIT_K(t_) do { if ((t_) >= 0 && (t_) < nt) { _Pragma("unroll") for (int i_ = 0; i_ < 2; ++i_) *(LAS u32x4*)(lds + ((t_) & 1) * KBYTES + (sr + 32 * i_) * KSTR + sc16 * 16) = st.kreg[i_]; } } while (0)
#define ATT_COMMIT_V(t_) do { if ((t_) >= 0 && (t_) < nt) { _Pragma("unroll") for (int i_ = 0; i_ < 2; ++i_) *(LAS u32x4*)(lds + 2 * KBYTES + ((t_) & 1) * VBYTES + (sr + 32 * i_) * VSTR + sc16 * 16) = st.vreg[i_]; } } while (0)
    ATT_COMMIT_K(ct); ATT_COMMIT_V(ct - 1);
    ATT_ISSUE_K(ct + 1); ATT_ISSUE_V(ct);
#ifdef USE_L2_PREFETCH
    if ((sc16 & 7) == 0) {
        if (ct + 1 + PF_AHEAD < nt) { _Pragma("unroll") for (int i_ = 0; i_ < 2; ++i_) (void)*(const volatile unsigned*)((const char*)Kp + ATT_ROW(ct + 1 + PF_AHEAD, i_)); }
        if (ct + PF_AHEAD < nt && ct + PF_AHEAD >= 0) { _Pragma("unroll") for (int i_ = 0; i_ < 2; ++i_) (void)*(const volatile unsigned*)((const char*)Vp + ATT_ROW(ct + PF_AHEAD, i_)); }
    }
#endif
    const int t = tau + 1;
    if (t >= 0 && t < nt && ts.active(t)) {
        __builtin_amdgcn_s_setprio(1);
        const int ks = ts.kstart(t);
        if (ts.need_mask(t)) {
#pragma unroll
            for (int e = 0; e < 16; ++e) {
                const int kp0 = ks + crow(e, hi), kp1 = kp0 + 32;
                s0[e] = ts.valid(t, ks, kp0) ? s0[e] : NEGR; s1[e] = ts.valid(t, ks, kp1) ? s1[e] : NEGR;
            }
        }
        float mxa = max3f(s0[0], s0[1], s1[0]), mxb = max3f(s0[2], s0[3], s1[1]);
        mxa = max3f(mxa, s1[2], s1[3]);
#pragma unroll
        for (int e = 4; e < 16; e += 4) { mxa = max3f(mxa, s0[e], s0[e + 1]); mxb = max3f(mxb, s0[e + 2], s0[e + 3]); mxa = max3f(mxa, s1[e], s1[e + 1]); mxb = max3f(mxb, s1[e + 2], s1[e + 3]); }
        float mx = max2f(mxa, mxb);
        mx = xhalf_max(mx);
        const float mn = max2f(m, mx * SC);
        if (__any(mn > m)) {
            const float a = __builtin_amdgcn_exp2f(m - mn); l *= a; m = mn;
#pragma unroll
            for (int b = 0; b < 4; ++b)
#pragma unroll
                for (int e = 0; e < 16; ++e) O[b][e] *= a;
        }
        float ps = 0.f, ps1 = 0.f;
#pragma unroll
        for (int e = 0; e < 16; ++e) { s0[e] = __builtin_amdgcn_exp2f(__builtin_fmaf(s0[e], SC, -m)); s1[e] = __builtin_amdgcn_exp2f(__builtin_fmaf(s1[e], SC, -m)); ps += s0[e]; ps1 += s1[e]; }
        l += ps + ps1;
#ifdef PROBE_EXP2
        { float d2 = 0.f;
#pragma unroll
          for (int e = 0; e < 16; ++e) d2 += __builtin_amdgcn_exp2f(s0[e] * 0.5f) + __builtin_amdgcn_exp2f(s1[e] * 0.5f);
          asm volatile("" :: "v"(d2)); }
#endif
        P[0] = pack8(s0, 0); P[1] = pack8(s0, 8); P[2] = pack8(s1, 0); P[3] = pack8(s1, 8);
        __builtin_amdgcn_s_setprio(0);
    }
}
template <class TS>
__device__ __forceinline__ void flash_pass(LAS unsigned char* lds, const bf16_t* Kp, const bf16_t* Vp, long krow0, int kstride,
                                           const bf16x8 (&qf)[8], const TS& ts, f32x16 (&O)[4], float& m, float& l, const int tid) {
#define ATT_BAR() do { asm volatile("s_waitcnt lgkmcnt(0)" ::: "memory"); __builtin_amdgcn_s_barrier(); asm volatile("" ::: "memory"); } while (0)
    const int lane = tid & 63, hi = lane >> 5, grp = __builtin_amdgcn_readfirstlane(tid >> 8);
    const int sr = tid >> 4, sc16 = tid & 15;
    Stage st;
    const int nt = ts.n();
    ATT_ISSUE_K(0); ATT_COMMIT_K(0); ATT_ISSUE_K(1); ATT_ISSUE_V(0);
    ATT_BAR();
    const int kro = (lane & 31) * KSTR + hi * 16;
    const int vro = (4 * hi + ((lane & 15) >> 2)) * VSTR + (((lane >> 4) & 1) * 16 + (lane & 3) * 4) * 2;
    f32x16 s0, s1; bf16x8 P[4];
#pragma unroll
    for (int q = 0; q < 4; ++q) P[q] = (bf16x8){0, 0, 0, 0, 0, 0, 0, 0};
    if (grp == 0) {
        for (int tau = -1; tau < nt; ++tau) {
            m_block(lds, ts, tau, nt, qf, O, s0, s1, P, kro, vro);
            v_block(lds, ts, tau, tau + 2, nt, Kp, Vp, krow0, kstride, st, O, s0, s1, P, m, l, sr, sc16, hi);
            ATT_BAR();
        }
    } else {
        for (int tau = -1; tau < nt; ++tau) {
            v_block(lds, ts, tau - 1, tau + 2, nt, Kp, Vp, krow0, kstride, st, O, s0, s1, P, m, l, sr, sc16, hi);
            m_block(lds, ts, tau, nt, qf, O, s0, s1, P, kro, vro);
            ATT_BAR();
        }
    }
#undef ATT_BAR
#undef ATT_ROW
#undef ATT_ISSUE_K
#undef ATT_ISSUE_V
#undef ATT_COMMIT_K
#undef ATT_COMMIT_V
}

__device__ __forceinline__ void zero_state(f32x16 (&O)[4], float& m, float& l) {
#pragma unroll
    for (int b = 0; b < 4; ++b)
#pragma unroll
        for (int e = 0; e < 16; ++e) O[b][e] = 0.f;
    m = NEG; l = 0.f;
}
__device__ __forceinline__ void store_o(const f32x16 (&O)[4], float scale, bf16_t* dst, int hi) {
#pragma unroll
    for (int b = 0; b < 4; ++b)
#pragma unroll
        for (int g = 0; g < 4; ++g) { u32x2 w; w.x = cvtpk(O[b][4 * g] * scale, O[b][4 * g + 1] * scale); w.y = cvtpk(O[b][4 * g + 2] * scale, O[b][4 * g + 3] * scale);
            *(u32x2*)(dst + 32 * b + 8 * g + 4 * hi) = w; }
}

struct TSDil {
    static constexpr bool CLAMP = true;
    int k0, qlo, qpos;
    __device__ __forceinline__ int n() const { return 6; }
    __device__ __forceinline__ int kstart(int t) const { return k0 + 64 * t; }
    __device__ __forceinline__ bool active(int t) const { const int ks = k0 + 64 * t; return ks <= qlo + 31 && ks + 63 >= qlo - 128; }
    __device__ __forceinline__ bool need_mask(int) const { return true; }
    __device__ __forceinline__ bool valid(int, int, int kpos) const { const int d = qpos - kpos; return d >= 0 && d <= 128 && kpos >= 0; }
};
struct TSCausal {
    static constexpr bool CLAMP = false;
    int nt, qpos, wqhi;
    __device__ __forceinline__ int n() const { return nt; }
    __device__ __forceinline__ int kstart(int t) const { return 64 * t; }
    __device__ __forceinline__ bool active(int t) const { return 64 * t <= wqhi; }
    __device__ __forceinline__ bool need_mask(int t) const { return 64 * t + 63 > wqhi - 31; }
    __device__ __forceinline__ bool valid(int, int, int kpos) const { return kpos <= qpos; }
};
struct TSMoba {
    static constexpr bool CLAMP = false;
    const LAS int* list; int nt, qb, qpos, wqhi; unsigned wmask, lmask, amask;
    __device__ __forceinline__ int n() const { return nt; }
    __device__ __forceinline__ int kstart(int t) const { return list[t]; }
    __device__ __forceinline__ bool active(int t) const { const int ks = list[t], blk = ks >> 8; return blk == qb ? ks <= wqhi : ((wmask >> blk) & 1u) != 0u; }
    __device__ __forceinline__ bool need_mask(int t) const { const int ks = list[t], blk = ks >> 8; return blk == qb ? ks + 63 > wqhi - 31 : ((amask >> blk) & 1u) == 0u; }
    __device__ __forceinline__ bool valid(int, int ks, int kpos) const { const int blk = ks >> 8; return blk == qb ? kpos <= qpos : ((lmask >> blk) & 1u) != 0u; }
};

#ifndef DP_SOFTMAX_COLS
#define DP_SOFTMAX_COLS 64
#endif
constexpr int DP_NBP = DP_SOFTMAX_COLS / 32, DP_NBC = 8 - DP_NBP;
constexpr int VS2 = 576, VB2 = 64 * VS2, DP_V = 2 * KBYTES, DP_P = DP_V + 2 * VB2, DP_PW = 5120, DP_PSLOT = 4 * DP_PW, DP_END = DP_P + 2 * DP_PSLOT;
#define DP_BAR() do { asm volatile("s_waitcnt lgkmcnt(0)" ::: "memory"); __builtin_amdgcn_s_barrier(); asm volatile("" ::: "memory"); } while (0)
template <int NB, int B0>
__device__ __forceinline__ void dp_pv(f32x16 (&O)[NB], const LAS unsigned char* vb, const bf16x8 (&P)[4]) {
    constexpr int NP = NB / 2, NS = 4 * NP;
    s16x4 fl[2][2], fh[2][2];
#pragma unroll
    for (int b = 0; b < 2; ++b) { fl[0][b] = vtr(vb + (B0 + b) * 64); fh[0][b] = vtr(vb + 8 * VS2 + (B0 + b) * 64); }
    __builtin_amdgcn_sched_barrier(0);
#pragma unroll
    for (int st = 0; st < NS; ++st) {
        const int q = st / NP, bp = st % NP;
        if (st < NS - 1) {
            const int qn = (st + 1) / NP, bn = (st + 1) % NP;
#pragma unroll
            for (int b = 0; b < 2; ++b) { fl[(st + 1) & 1][b] = vtr(vb + (16 * qn) * VS2 + (B0 + 2 * bn + b) * 64); fh[(st + 1) & 1][b] = vtr(vb + (16 * qn + 8) * VS2 + (B0 + 2 * bn + b) * 64); }
        }
#pragma unroll
        for (int b = 0; b < 2; ++b) {
            const s16x4 lo = fl[st & 1][b], hh = fh[st & 1][b];
            const bf16x8 vf = (bf16x8){lo[0], lo[1], lo[2], lo[3], hh[0], hh[1], hh[2], hh[3]};
            O[2 * bp + b] = __builtin_amdgcn_mfma_f32_32x32x16_bf16(vf, P[q], O[2 * bp + b], 0, 0, 0);
        }
        __builtin_amdgcn_sched_barrier(0);
    }
}
template <int NB, int B0>
__device__ __forceinline__ void dp_post(f32x16 (&O)[NB], const float inv_l, const int pr, const float lam, const float post_scale, float* parkt, const float* sg, bf16_t* dst,
                                        LAS float* ssx, const int tid, const int hi) {
    f32x4* pk = (f32x4*)parkt;
    if (pr == 0) {
#pragma unroll
        for (int bb = 0; bb < NB; ++bb)
#pragma unroll
            for (int g4 = 0; g4 < 4; ++g4) pk[bb * 4 + g4] = (f32x4){O[bb][4 * g4], O[bb][4 * g4 + 1], O[bb][4 * g4 + 2], O[bb][4 * g4 + 3]} * inv_l;
    } else {
        float ss = 0.f;
#pragma unroll
        for (int bb = 0; bb < NB; ++bb)
#pragma unroll
            for (int g4 = 0; g4 < 4; ++g4) { const f32x4 pv = pk[bb * 4 + g4];
#pragma unroll
                for (int i = 0; i < 4; ++i) { const float v = pv[i] - lam * (O[bb][4 * g4 + i] * inv_l); O[bb][4 * g4 + i] = v; ss += v * v; } }
        ss = xhalf_sum(ss);
        ssx[tid] = ss;
        DP_BAR();
        ss += ssx[tid ^ 256];
        DP_BAR();
        const float rs = post_scale / sqrtf(ss * (1.0f / 256.0f) + 1e-5f);
#pragma unroll
        for (int bb = 0; bb < NB; ++bb)
#pragma unroll
            for (int g4 = 0; g4 < 4; ++g4) {
                const int dv = 32 * (B0 + bb) + 8 * g4 + 4 * hi;
                const f32x4 ga = *(const f32x4*)(sg + dv);
                u32x2 w; w.x = cvtpk(O[bb][4 * g4] * ga[0] * rs, O[bb][4 * g4 + 1] * ga[1] * rs); w.y = cvtpk(O[bb][4 * g4 + 2] * ga[2] * rs, O[bb][4 * g4 + 3] * ga[3] * rs);
                *(u32x2*)(dst + dv) = w;
            }
    }
}
__device__ __forceinline__ void diff_pass(LAS unsigned char* lds, const bf16_t* Kp, const bf16_t* Vp, const bf16_t* Qp, const int row0, const int qb, const int pr, const float lam, const float post_scale,
                                          float* park, const float* sg, bf16_t* att_head  , const int tid) {
    const int lane = tid & 63, hi = lane >> 5, grp = __builtin_amdgcn_readfirstlane(tid >> 8), pw = __builtin_amdgcn_readfirstlane(tid >> 6) & 3;
    const int nt = 2 * (qb + 1), qlo = 128 * qb + 32 * pw, qpos = qlo + (lane & 31), wqhi = qlo + 31;
    LAS unsigned char* pbase = lds + DP_P + pw * DP_PW + lane * 16;
    LAS float* ssx = (LAS float*)(lds + DP_END);
    const int vro = (4 * hi + ((lane & 15) >> 2)) * VS2 + (((lane >> 4) & 1) * 16 + (lane & 3) * 4) * 2;
    int vr = (tid - 256) >> 5, vc = tid & 31, sr = (tid - 256) >> 4, sc16 = tid & 15;
    asm volatile("" : "+v"(vr), "+v"(vc), "+v"(sr), "+v"(sc16));
#define DP_VOFF(t_, i_) (((unsigned)(row0 + 64 * (t_) + vr + 8 * (i_)) * (unsigned)NQKV + (unsigned)(vc * 8)) * 2u)
#define DP_ISSUE_V(t_) do { if ((t_) < nt) { _Pragma("unroll") for (int i_ = 0; i_ < 8; ++i_) vreg[i_] = *(const u32x4*)((const char*)Vp + DP_VOFF(t_, i_)); } } while (0)
#define DP_COMMIT_V(t_) do { if ((t_) < nt) { _Pragma("unroll") for (int i_ = 0; i_ < 8; ++i_) *(LAS u32x4*)(lds + DP_V + ((t_) & 1) * VB2 + (vr + 8 * i_) * VS2 + vc * 16) = vreg[i_]; } } while (0)
#define DP_KOFF(t_, i_) (((unsigned)(row0 + 64 * (t_) + sr + 16 * (i_)) * (unsigned)NQKV + (unsigned)(sc16 * 8)) * 2u)
#define DP_ISSUE_K(t_) do { if ((t_) < nt) { _Pragma("unroll") for (int i_ = 0; i_ < 4; ++i_) kreg[i_] = *(const u32x4*)((const char*)Kp + DP_KOFF(t_, i_)); } } while (0)
#define DP_COMMIT_K(t_) do { if ((t_) < nt) { _Pragma("unroll") for (int i_ = 0; i_ < 4; ++i_) *(LAS u32x4*)(lds + ((t_) & 1) * KBYTES + (sr + 16 * i_) * KSTR + sc16 * 16) = kreg[i_]; } } while (0)
    if (grp == 0) {
        bf16x8 qf[8]; load_q(qf, Qp, (long)row0 + qpos, hi);
        DP_BAR();
        const int kro = (lane & 31) * KSTR + hi * 16;
        f32x16 O[2]; f32x16 s0, s1; bf16x8 P[4]; float m = NEG, l = 0.f;
#pragma unroll
        for (int e = 0; e < 16; ++e) { O[0][e] = 0.f; O[1][e] = 0.f; }
        (void)O;
#pragma unroll
        for (int q = 0; q < 4; ++q) P[q] = (bf16x8){0, 0, 0, 0, 0, 0, 0, 0};
        for (int tau = -1; tau < nt; ++tau) {
            const int t = tau + 1;
            const bool act = t < nt && 64 * t <= wqhi;
            const LAS unsigned char* kb = lds + (t & 1) * KBYTES + kro;
            bf16x8 fk[2][4];
            if (act) {
#pragma unroll
                for (int j = 0; j < 2; ++j) { fk[0][2 * j] = *(const LAS bf16x8*)(kb + j * 32); fk[0][2 * j + 1] = *(const LAS bf16x8*)(kb + 32 * KSTR + j * 32); }
            }
            __builtin_amdgcn_sched_barrier(0);
            if (DP_NBP == 2) { if (tau >= 0 && 64 * tau <= wqhi) dp_pv<2, 0>(O, lds + DP_V + (tau & 1) * VB2 + vro, P); }
#pragma unroll
            for (int e = 0; e < 16; ++e) { s0[e] = 0.f; s1[e] = 0.f; }
            if (act) {
#pragma unroll
                for (int c2 = 0; c2 < 4; ++c2) {
                    if (c2 < 3) {
#pragma unroll
                        for (int j = 0; j < 2; ++j) { fk[(c2 + 1) & 1][2 * j] = *(const LAS bf16x8*)(kb + (2 * (c2 + 1) + j) * 32); fk[(c2 + 1) & 1][2 * j + 1] = *(const LAS bf16x8*)(kb + 32 * KSTR + (2 * (c2 + 1) + j) * 32); }
                    }
#pragma unroll
                    for (int j = 0; j < 2; ++j) {
                        s0 = __builtin_amdgcn_mfma_f32_32x32x16_bf16(fk[c2 & 1][2 * j], qf[2 * c2 + j], s0, 0, 0, 0);
                        s1 = __builtin_amdgcn_mfma_f32_32x32x16_bf16(fk[c2 & 1][2 * j + 1], qf[2 * c2 + j], s1, 0, 0, 0);
                    }
                    __builtin_amdgcn_sched_barrier(0);
                }
            }
            if (act) {
                const int ks = 64 * t;
                if (ks + 63 > qlo) {
#pragma unroll
                    for (int e = 0; e < 16; ++e) { const int kp0 = ks + crow(e, hi), kp1 = kp0 + 32; s0[e] = kp0 <= qpos ? s0[e] : NEGR; s1[e] = kp1 <= qpos ? s1[e] : NEGR; }
                }
                float mxa = max3f(s0[0], s0[1], s1[0]), mxb = max3f(s0[2], s0[3], s1[1]);
                mxa = max3f(mxa, s1[2], s1[3]);
#pragma unroll
                for (int e = 4; e < 16; e += 4) { mxa = max3f(mxa, s0[e], s0[e + 1]); mxb = max3f(mxb, s0[e + 2], s0[e + 3]); mxa = max3f(mxa, s1[e], s1[e + 1]); mxb = max3f(mxb, s1[e + 2], s1[e + 3]); }
                float mx = max2f(mxa, mxb);
                mx = xhalf_max(mx);
                const float mn = max2f(m, mx * SC);
                const float a = __builtin_amdgcn_exp2f(m - mn);
                if (DP_NBP == 2) {
                    if (__any(mn > m)) {
                        l *= a; m = mn;
#pragma unroll
                        for (int e = 0; e < 16; ++e) { O[0][e] *= a; O[1][e] *= a; }
                    }
                } else { l *= a; m = mn; }
                float ps = 0.f, ps1 = 0.f;
#pragma unroll
                for (int e = 0; e < 16; ++e) { s0[e] = __builtin_amdgcn_exp2f(__builtin_fmaf(s0[e], SC, -m)); s1[e] = __builtin_amdgcn_exp2f(__builtin_fmaf(s1[e], SC, -m)); ps += s0[e]; ps1 += s1[e]; }
                l += ps + ps1;
                P[0] = pack8(s0, 0); P[1] = pack8(s0, 8); P[2] = pack8(s1, 0); P[3] = pack8(s1, 8);
                LAS unsigned char* pp = pbase + (t & 1) * DP_PSLOT;
#pragma unroll
                for (int q = 0; q < 4; ++q) *(LAS bf16x8*)(pp + q * 1024) = P[q];
                *(LAS float*)(pp + 4 * 1024) = a;
            }
            DP_BAR();
        }
        l = xhalf_sum(l);
        const float inv_l = 1.0f / l;
        *(LAS float*)(pbase + 4 * 1024 + 4) = inv_l;
        DP_BAR();
        int tl = tid; asm volatile("" : "+v"(tl));
        if (DP_NBP == 2) dp_post<2, 0>(O, inv_l, pr, lam, post_scale, park + (size_t)tl * 128, sg, att_head + (size_t)qpos * DM, ssx, tid, hi);
        else if (pr == 1) { ssx[tid] = 0.f; DP_BAR(); DP_BAR(); }
    } else {
        f32x16 O[DP_NBC];
#pragma unroll
        for (int b = 0; b < DP_NBC; ++b)
#pragma unroll
            for (int e = 0; e < 16; ++e) O[b][e] = 0.f;
        u32x4 vreg[8], kreg[4];
        DP_ISSUE_K(0); DP_COMMIT_K(0); DP_ISSUE_K(1); DP_ISSUE_V(0);
        DP_BAR();
        for (int tau = -1; tau < nt; ++tau) {
            asm volatile("" : "+v"(vr), "+v"(vc), "+v"(sr), "+v"(sc16));
            DP_COMMIT_K(tau + 2); DP_COMMIT_V(tau + 1); DP_ISSUE_K(tau + 3); DP_ISSUE_V(tau + 2);
            if (tau >= 0 && 64 * tau <= wqhi) {
                const LAS unsigned char* pp = pbase + (tau & 1) * DP_PSLOT;
                bf16x8 P[4];
#pragma unroll
                for (int q = 0; q < 4; ++q) P[q] = *(const LAS bf16x8*)(pp + q * 1024);
                const float a = *(const LAS float*)(pp + 4 * 1024);
                if (__any(a != 1.0f)) {
#pragma unroll
                    for (int b = 0; b < DP_NBC; ++b)
#pragma unroll
                        for (int e = 0; e < 16; ++e) O[b][e] *= a;
                }
                dp_pv<DP_NBC, DP_NBP>(O, lds + DP_V + (tau & 1) * VB2 + vro, P);
            }
            DP_BAR();
        }
        DP_BAR();
        const float inv_l = *(const LAS float*)(pbase + 4 * 1024 + 4);
        int tl = tid; asm volatile("" : "+v"(tl));
        dp_post<DP_NBC, DP_NBP>(O, inv_l, pr, lam, post_scale, park + (size_t)tl * 128, sg, att_head + (size_t)qpos * DM, ssx, tid, hi);
    }
    DP_BAR();
#undef DP_VOFF
#undef DP_ISSUE_V
#undef DP_COMMIT_V
#undef DP_KOFF
#undef DP_ISSUE_K
#undef DP_COMMIT_K
}
#undef DP_BAR
}

#define XB_TMO      128
#define XB_XCNT(j)  (256  + 64 * (j))
#define XB_XSUB(j)  (1280 + 64 * (j))
#define XB_XGEN(j)  (2304 + 64 * (j))
#define XB_TOP      3328
#define XB_TOPGEN   3392
#define XCD_BAR_WORDS 3456
#define XB_SPIN_CAP (1u << 22)

__device__ __forceinline__ unsigned xb_ld(unsigned* p)              { return __hip_atomic_load(p, __ATOMIC_RELAXED, __HIP_MEMORY_SCOPE_AGENT); }
__device__ __forceinline__ unsigned xb_add(unsigned* p, unsigned v) { return __hip_atomic_fetch_add(p, v, __ATOMIC_RELAXED, __HIP_MEMORY_SCOPE_AGENT); }
__device__ __forceinline__ unsigned xb_xcc_id() { return (unsigned)__builtin_amdgcn_s_getreg((3 << 11) | 20) & 0xFu; }
#define XB_SPIN(cond, bar) do { unsigned _sp = 0; while (cond) { __builtin_amdgcn_s_sleep(1); \
    if ((++_sp & 255u) == 0u) { if (xb_ld(&(bar)[XB_TMO])) break; if (_sp > XB_SPIN_CAP) { atomicAdd(&(bar)[XB_TMO], 1u); break; } } } } while (0)

struct XcdBarrier {
    unsigned* bar; unsigned x;
    volatile LAS unsigned* st;
};

__device__ __forceinline__ XcdBarrier xcd_barrier_post(unsigned* bar, volatile LAS unsigned* st, const bool t0) {
    XcdBarrier b; b.bar = bar; b.x = xb_xcc_id(); b.st = st;
    if (t0) (void)xb_add(&bar[XB_XCNT(b.x)], 1u);
    return b;
}
__device__ __forceinline__ void xcd_barrier_complete(unsigned* bar, unsigned x, unsigned& nloc, unsigned& nx) {
    const unsigned G = gridDim.x * gridDim.y * gridDim.z;
    unsigned sum, cnt, mine, sp = 0u;
    for (;;) {
        sum = 0u; cnt = 0u; mine = 0u;
#pragma unroll
        for (unsigned j = 0; j < 16; ++j) { const unsigned c = xb_ld(&bar[XB_XCNT(j)]); sum += c; cnt += (c > 0u) ? 1u : 0u; mine = (j == x) ? c : mine; }
        if (sum == G) break;
        __builtin_amdgcn_s_sleep(1);
        if ((++sp & 255u) == 0u) { if (xb_ld(&bar[XB_TMO])) break; if (sp > XB_SPIN_CAP) { atomicAdd(&bar[XB_TMO], 1u); break; } }
    }
    nloc = mine > 0u ? mine : 1u; nx = cnt > 0u ? cnt : 1u;
}

__device__ __forceinline__ void xcd_barrier(const XcdBarrier& b, const bool t0) {
    asm volatile("s_waitcnt vmcnt(0)" ::: "memory");
    __syncthreads();
    if (t0) {
        unsigned* bar = b.bar;
        __builtin_amdgcn_s_waitcnt(0);
        unsigned nloc = b.st[0], nx = b.st[1];
        if (nloc == 0u) { xcd_barrier_complete(bar, b.x, nloc, nx); b.st[0] = nloc; b.st[1] = nx; }
        const unsigned old = xb_add(&bar[XB_XSUB(b.x)], 1u);
        const unsigned gen = old / nloc;
        if (old + 1u == (gen + 1u) * nloc) {
            __builtin_amdgcn_fence(__ATOMIC_RELEASE, "agent");
            asm volatile("s_waitcnt vmcnt(0)" ::: "memory");
            const unsigned og = xb_add(&bar[XB_TOP], 1u);
            const unsigned tg = og / nx;
            if (og + 1u == (tg + 1u) * nx) xb_add(&bar[XB_TOPGEN], 1u);
            else XB_SPIN(xb_ld(&bar[XB_TOPGEN]) == tg, bar);
            __builtin_amdgcn_fence(__ATOMIC_ACQUIRE, "agent");
            xb_add(&bar[XB_XGEN(b.x)], 1u);
            asm volatile("s_waitcnt vmcnt(0)" ::: "memory");
        } else {
            XB_SPIN(xb_ld(&bar[XB_XGEN(b.x)]) == gen, bar);
            __builtin_amdgcn_fence(__ATOMIC_ACQUIRE, "agent");
            asm volatile("s_waitcnt vmcnt(0)" ::: "memory");
        }
    }
    __syncthreads();
}

#define AS4 __attribute__((address_space(4)))
#define PHASE_WS() const AS4 unsigned char* ka_ = (const AS4 unsigned char*)__builtin_amdgcn_kernarg_segment_ptr(); asm volatile("" : "+s"(ka_)); unsigned char* ws = *(unsigned char* const AS4*)(ka_ + 152)
#define PIN(i) (*(const float* const AS4*)(ka_ + 8 * (i)))
#define XIN PIN(0)
#define HBUF (*(float* const AS4*)(ka_ + 144))
__global__ void __launch_bounds__(512) fwd_megakernel(Params P) {
    extern __shared__ __attribute__((aligned(16))) unsigned char lds_raw[];
    LAS unsigned char* lds = (LAS unsigned char*)lds_raw;
    cg::grid_group grid = cg::this_grid();
    grid.sync();
    const int G = gridDim.x, bx = blockIdx.x, NGW = G * 8;
    const int wave_s = __builtin_amdgcn_readfirstlane((int)threadIdx.x >> 6);
#define PHASE_IDS() PHASE_WS(); int tid; asm volatile("v_mbcnt_lo_u32_b32 %0, -1, 0\n\tv_mbcnt_hi_u32_b32 %0, -1, %0" : "=v"(tid)); tid += wave_s * 64; const int lane = tid & 63, wave = wave_s, hi = lane >> 5, gw = bx * 8 + wave; (void)hi; (void)gw; (void)lane
    volatile LAS unsigned* xst = (volatile LAS unsigned*)(lds + 152576);
    { int l_; asm volatile("v_mbcnt_lo_u32_b32 %0, -1, 0\n\tv_mbcnt_hi_u32_b32 %0, -1, %0" : "=v"(l_)); if ((l_ + wave_s * 64) < 2) xst[l_] = 0u; }
    __syncthreads();
    XcdBarrier xbar;
    { int l_; asm volatile("v_mbcnt_lo_u32_b32 %0, -1, 0\n\tv_mbcnt_hi_u32_b32 %0, -1, %0" : "=v"(l_)); PHASE_WS(); xbar = xcd_barrier_post((unsigned*)(ws + WS_CTL), xst, (l_ + wave_s * 64) == 0); }
#define XN ((bf16_t*)(ws + WS_XN))
#define BIG ((bf16_t*)(ws + WS_BIG))
#define ATT ((bf16_t*)(ws + WS_ATT))
#define PART ((bf16_t*)(ws + WS_PART))
#define LSE ((float*)(ws + WS_LSE))
#define COS ((float*)(ws + WS_ROPE))
#define SIN (COS + SEQ * 64)
#define KMEAN ((float*)(ws + WS_KMEAN))
    constexpr unsigned long long ROPE_EVEN = 0x000000FFFF00FFFFull;
    constexpr unsigned long long ROPE_ODD = 0x00000000FFFFFFFFull;

    {
        PHASE_IDS();
        LAS float* scr = (LAS float*)(lds + wave * 8448);
#ifndef NO_TRANSP
        for (int rep = 0; rep < REP_PRO; ++rep) {
        for (int l = 0; l < 2; ++l) {
            transpose_items<1>(PIN(2) + (size_t)l * DM * 2 * DFF, DM, 2 * DFF, (bf16_t*)(ws + WS_FFA_IN + l * SZ_WIN), 0, scr, gw, NGW, lane);
            transpose_items<0>(PIN(3) + (size_t)l * DFF * DM, DFF, DM, (bf16_t*)(ws + WS_FFA_OUT + l * SZ_WOUT), 0, scr, gw, NGW, lane);
            transpose_items<1>(PIN(15) + (size_t)l * DM * 2 * DFF, DM, 2 * DFF, (bf16_t*)(ws + WS_FFB_IN + l * SZ_WIN), 0, scr, gw, NGW, lane);
            transpose_items<0>(PIN(16) + (size_t)l * DFF * DM, DFF, DM, (bf16_t*)(ws + WS_FFB_OUT + l * SZ_WOUT), 0, scr, gw, NGW, lane);
        }
        transpose_items<2>(PIN(5), DM, NQKV, (bf16_t*)(ws + WS_MIX_IN), ROPE_EVEN, scr, gw, NGW, lane);
        transpose_items<2>(PIN(7), DM, NQKV, (bf16_t*)(ws + WS_MIX_IN + SZ_WMIN), ROPE_ODD, scr, gw, NGW, lane);
        transpose_items<0>(PIN(6), DM, DM, (bf16_t*)(ws + WS_MIX_OUT), 0, scr, gw, NGW, lane);
        transpose_items<0>(PIN(8), DM, DM, (bf16_t*)(ws + WS_MIX_OUT + SZ_WMOUT), 0, scr, gw, NGW, lane);
        }
#endif
#ifndef NO_ROPETAB
        for (int idx = bx * 512 + tid; idx < SEQ * 64; idx += G * 512) {
            const int pos = idx >> 6, j = idx & 63;
            const float inv = (float)pow(10000.0, -(double)j / 64.0);
            const float ang = (float)pos * inv;
            const double a = (double)ang, n = rint(a * 0.15915494309189535);
            const double r = (a - n * 6.283185307179586) - n * 2.4492935982947064e-16;
            COS[idx] = (float)cos(r); SIN[idx] = (float)sin(r);
        }
#endif
        norm_phase<false>(XIN, PIN(1), XN, gw, NGW, lane);
    }
    GSYNC();

    for (int layer = 0; layer < 2; ++layer) {
        {
            PHASE_WS();
            pg8::Gemm g{XN, (const bf16_t*)(ws + WS_FFA_IN + layer * SZ_WIN), MTOK, 2 * DFF, DM}; pg8::StaticOrder S; { int g_ = G, b_ = bx; asm volatile("" : "+s"(g_), "+s"(b_)); S.init(MTOK, 2 * DFF, g_, b_); }
            pg8::EpiSwiGLU E{BIG, DFF};
#ifndef NO_EPISWIGLU
            for (int rep = 0; rep < REP_SWI; ++rep) pg8::gemm_phase<pg8::EpiSwiGLU, pg8::StaticOrder, true, true>(lds, g, S, E, wave_s);
#endif
        }
        GSYNC();
        {
            PHASE_WS();
            pg8::Gemm g{BIG, (const bf16_t*)(ws + WS_FFA_OUT + layer * SZ_WOUT), MTOK, DM, DFF}; pg8::StaticOrder S; { int g_ = G, b_ = bx; asm volatile("" : "+s"(g_), "+s"(b_)); S.init(MTOK, DM, g_, b_); }
            pg8::EpiResid E{layer == 0 ? XIN : HBUF, HBUF, DM, 0.5f};
#ifndef NO_EPIRESID
            for (int rep = 1; rep < REP_RES; ++rep) { pg8::EpiResid E0 = E; E0.scale = 0.f; pg8::gemm_phase<pg8::EpiResid, pg8::StaticOrder, true, true>(lds, g, S, E0, wave_s); }
            pg8::gemm_phase<pg8::EpiResid, pg8::StaticOrder, true, true>(lds, g, S, E, wave_s);
#endif
        }
        GSYNC();
        { PHASE_IDS(); for (int rep = 0; rep < REP_NORM; ++rep) norm_phase<false>(HBUF, PIN(4) + layer * DM, XN, gw, NGW, lane); }
        GSYNC();
        {
            PHASE_WS();
            pg8::Gemm g{XN, (const bf16_t*)(ws + WS_MIX_IN + layer * SZ_WMIN), MTOK, NQKV, DM}; pg8::StaticOrder S; { int g_ = G, b_ = bx; asm volatile("" : "+s"(g_), "+s"(b_)); S.init(MTOK, NQKV, g_, b_); }
            pg8::EpiQKV E{BIG, NQKV, COS, SIN, layer == 0 ? ROPE_EVEN : ROPE_ODD};
#ifndef NO_EPIQKV
            for (int rep = 0; rep < REP_QKV; ++rep) pg8::gemm_phase<pg8::EpiQKV, pg8::StaticOrder, true, true>(lds, g, S, E, wave_s);
#endif
        }
        GSYNC();
        if (layer == 0) {
            PHASE_IDS();
            for (int rep = 0; rep < REP_DIL; ++rep) {
            for (int it = bx; it < 512; it += G) {
                const int b = it >> 8, h = (it >> 5) & 7, blk = it & 31, c = tid & 127, rg = tid >> 7;
                const bf16_t* kp = BIG + (size_t)(b * SEQ + blk * 256 + rg * 64) * NQKV + 4096 + h * 128 + c;
                float s = 0.f;
                for (int r = 0; r < 64; ++r) s += bf2f(kp[(size_t)r * NQKV]);
                LAS float* red = (LAS float*)lds;
                red[rg * 128 + c] = s; __syncthreads();
                if (tid < 128) KMEAN[(size_t)it * 128 + tid] = (red[tid] + red[128 + tid] + red[256 + tid] + red[384 + tid]) * (1.0f / 256.0f);
                __syncthreads();
            }
#ifndef NO_DIL
            for (int un = bx; un < 1536; un += G) {
                const int u = un & 31, br = (un >> 5) % 3, bh = un / 96, b = bh >> 3, h = bh & 7;
                const int dl = br == 0 ? 1 : (br == 1 ? 4 : 16);
                const int upr = 32 / dl, res = u / upr, ub = u % upr;
                const long row0 = (long)b * SEQ + res;
                const int qlo = 256 * ub + 32 * wave, qpos = qlo + (lane & 31);
                bf16x8 qf[8]; att::load_q(qf, BIG + h * 128, row0 + (long)qpos * dl, hi);
                f32x16 O[4]; float m, l; att::zero_state(O, m, l);
                att::TSDil ts{256 * ub - 128, qlo, qpos};
                att::flash_pass(lds, BIG + 1024 + h * 128, BIG + 2048 + h * 128, row0, dl, qf, ts, O, m, l, tid);
                l = att::xhalf_sum(l);
                const long grow = row0 + (long)qpos * dl;
                att::store_o(O, 1.0f / l, PART + ((size_t)br * MTOK + grow) * 1024 + h * 128, hi);
                if (hi == 0) LSE[((size_t)br * MTOK + grow) * 8 + h] = m + log2f(l);
            }
#endif
            }
        } else {
            PHASE_IDS();
#ifndef NO_DIFF
            const float lam_init = 0.35550906759096927f;
            float d1 = 0.f, d2 = 0.f;
            for (int i = 0; i < 128; ++i) { d1 += PIN(9)[i] * PIN(10)[i]; d2 += PIN(11)[i] * PIN(12)[i]; }
            const float lam = __uint_as_float(__builtin_amdgcn_readfirstlane(__float_as_uint(expf(d1) - expf(d2) + lam_init)));
            float* park = (float*)PART + (size_t)bx * 128 * 512;
            for (int rep = 0; rep < REP_DIFF; ++rep)
            for (int un = bx; un < 1024; un += G) {
                const int j4 = un >> 8, c8 = un & 255, bh = c8 >> 4, x16 = c8 & 15, b = bh >> 3, h = bh & 7;
                const int qb = j4 == 0 ? 63 - x16 : (j4 == 1 ? 32 + x16 : (j4 == 2 ? 31 - x16 : x16));
                const int row0 = b * SEQ;
#pragma unroll 1
                for (int pr = 0; pr < 2; ++pr)
                    att::diff_pass(lds, BIG + 2048 + h * 256 + pr * 128, BIG + 4096 + h * 256, BIG + h * 256 + pr * 128, row0, qb, pr, lam, 1.0f - lam_init, park, PIN(13), ATT + (size_t)row0 * DM + h * 256, tid);
            }
#endif
        }
        GSYNC();
        if (layer == 0) {
            PHASE_IDS();
            for (int rep = 0; rep < REP_MOBA; ++rep) {
#pragma unroll 2
            for (int idx = bx * 512 + tid; idx < MTOK * 128; idx += G * 512) {
                const int row = idx >> 7, h = (idx >> 4) & 7, ch = idx & 15;
                float L[3]; u32x4 pv[3];
#pragma unroll
                for (int br = 0; br < 3; ++br) { L[br] = LSE[((size_t)br * MTOK + row) * 8 + h]; pv[br] = *(const u32x4*)(PART + ((size_t)br * MTOK + row) * 1024 + h * 128 + ch * 8); }
                const float mx = fmaxf(L[0], fmaxf(L[1], L[2]));
                float w[3]; float sw = 0.f;
#pragma unroll
                for (int br = 0; br < 3; ++br) { w[br] = __builtin_amdgcn_exp2f(L[br] - mx); sw += w[br]; }
                const float isw = 1.0f / sw;
                float o[8];
#pragma unroll
                for (int i = 0; i < 8; ++i) o[i] = 0.f;
#pragma unroll
                for (int br = 0; br < 3; ++br) { const float wb = w[br] * isw;
#pragma unroll
                    for (int i = 0; i < 4; ++i) { const unsigned wd = pv[br][i]; o[2 * i] += wb * bf2f((unsigned short)(wd & 0xffffu)); o[2 * i + 1] += wb * bf2f((unsigned short)(wd >> 16)); } }
                u32x4 r; r.x = pk2(o[0], o[1]); r.y = pk2(o[2], o[3]); r.z = pk2(o[4], o[5]); r.w = pk2(o[6], o[7]);
                *(u32x4*)(ATT + (size_t)row * DM + h * 128 + ch * 8) = r;
            }
#ifndef NO_MOBA
            LAS float* kmL = (LAS float*)(lds + 77824);
            LAS unsigned* selL = (LAS unsigned*)(lds + 94208);
            LAS unsigned* wmL = (LAS unsigned*)(lds + 95232);
            LAS int* listL = (LAS int*)(lds + 95296);
            for (int un = bx; un < 512; un += G) {
                const int sel = un & 255, bh = sel >> 4, qb = (un < 256) ? 31 - (sel & 15) : (sel & 15), b = bh >> 3, h = bh & 7;
                const long row0 = (long)b * SEQ;
                for (int i = tid; i < qb * 128; i += 512) kmL[i] = KMEAN[(size_t)(bh * 32) * 128 + i];
                __syncthreads();
                {
                    const int q = tid >> 1, part = tid & 1;
                    const bf16_t* qp = BIG + (size_t)(row0 + qb * 256 + q) * NQKV + 3072 + h * 128 + 64 * part;
                    float qv[64];
#pragma unroll
                    for (int c = 0; c < 8; ++c) { const u32x4 w = *(const u32x4*)(qp + 8 * c);
#pragma unroll
                        for (int i = 0; i < 4; ++i) { qv[8 * c + 2 * i] = bf2f((unsigned short)(w[i] & 0xffffu)); qv[8 * c + 2 * i + 1] = bf2f((unsigned short)(w[i] >> 16)); } }
                    float v0 = -3e38f, v1 = -3e38f, v2 = -3e38f; int i0 = -1, i1 = -1, i2 = -1;
                    for (int j = 0; j < qb; ++j) {
                        const LAS float* km = kmL + j * 128 + 64 * part; float d = 0.f;
#pragma unroll
                        for (int i = 0; i < 64; ++i) d += qv[i] * km[i];
                        d += shfl_xor_f(d, 1, lane);
                        if (d > v0) { v2 = v1; i2 = i1; v1 = v0; i1 = i0; v0 = d; i0 = j; }
                        else if (d > v1) { v2 = v1; i2 = i1; v1 = d; i1 = j; }
                        else if (d > v2) { v2 = d; i2 = j; }
                    }
                    unsigned mk = 0u; if (i0 >= 0) mk |= 1u << i0; if (i1 >= 0) mk |= 1u << i1; if (i2 >= 0) mk |= 1u << i2;
                    if (part == 0) selL[q] = mk;
                }
                __syncthreads();
                const unsigned lmask = selL[32 * wave + (lane & 31)];
                unsigned wm = lmask, am = lmask;
#pragma unroll
                for (int o = 1; o < 64; o <<= 1) { wm |= (unsigned)shfl_xor_i((int)wm, o, lane); am &= (unsigned)shfl_xor_i((int)am, o, lane); }
                if (lane == 0) wmL[wave] = wm;
                __syncthreads();
                if (tid == 0) {
                    unsigned U = 0u; for (int w = 0; w < 8; ++w) U |= wmL[w];
                    int n = 0;
                    for (int j = 0; j < qb; ++j) if ((U >> j) & 1u) { for (int i = 0; i < 4; ++i) listL[n++] = 256 * j + 64 * i; }
                    for (int i = 0; i < 4; ++i) listL[n++] = 256 * qb + 64 * i;
                    listL[130] = n;
                }
                __syncthreads();
                const int qlo = 256 * qb + 32 * wave, qpos = qlo + (lane & 31);
                bf16x8 qf[8]; att::load_q(qf, BIG + 3072 + h * 128, row0 + qpos, hi);
                f32x16 O[4]; float m, l; att::zero_state(O, m, l);
                att::TSMoba ts{listL, listL[130], qb, qpos, qlo + 31, wm, lmask, am};
                att::flash_pass(lds, BIG + 4096 + h * 128, BIG + 5120 + h * 128, row0, 1, qf, ts, O, m, l, tid);
                l = att::xhalf_sum(l);
                att::store_o(O, 1.0f / l, ATT + (size_t)(row0 + qpos) * DM + 1024 + h * 128, hi);
                __syncthreads();
            }
#endif
            }
            GSYNC();
        }
        {
            PHASE_WS();
            pg8::Gemm g{ATT, (const bf16_t*)(ws + WS_MIX_OUT + layer * SZ_WMOUT), MTOK, DM, DM}; pg8::StaticOrder S; { int g_ = G, b_ = bx; asm volatile("" : "+s"(g_), "+s"(b_)); S.init(MTOK, DM, g_, b_); }
            pg8::EpiResid E{HBUF, HBUF, DM, 1.0f};
#ifndef NO_EPIRESID
            for (int rep = 1; rep < REP_RES; ++rep) { pg8::EpiResid E0 = E; E0.scale = 0.f; pg8::gemm_phase<pg8::EpiResid, pg8::StaticOrder, true, true>(lds, g, S, E0, wave_s); }
            pg8::gemm_phase<pg8::EpiResid, pg8::StaticOrder, true, true>(lds, g, S, E, wave_s);
#endif
        }
        GSYNC();
        { PHASE_IDS(); for (int rep = 0; rep < REP_NORM; ++rep) norm_phase<false>(HBUF, PIN(14) + layer * DM, XN, gw, NGW, lane); }
        GSYNC();
        {
            PHASE_WS();
            pg8::Gemm g{XN, (const bf16_t*)(ws + WS_FFB_IN + layer * SZ_WIN), MTOK, 2 * DFF, DM}; pg8::StaticOrder S; { int g_ = G, b_ = bx; asm volatile("" : "+s"(g_), "+s"(b_)); S.init(MTOK, 2 * DFF, g_, b_); }
            pg8::EpiSwiGLU E{BIG, DFF};
#ifndef NO_EPISWIGLU
            for (int rep = 0; rep < REP_SWI; ++rep) pg8::gemm_phase<pg8::EpiSwiGLU, pg8::StaticOrder, true, true>(lds, g, S, E, wave_s);
#endif
        }
        GSYNC();
        {
            PHASE_WS();
            pg8::Gemm g{BIG, (const bf16_t*)(ws + WS_FFB_OUT + layer * SZ_WOUT), MTOK, DM, DFF}; pg8::StaticOrder S; { int g_ = G, b_ = bx; asm volatile("" : "+s"(g_), "+s"(b_)); S.init(MTOK, DM, g_, b_); }
            pg8::EpiResid E{HBUF, HBUF, DM, 0.5f};
#ifndef NO_EPIRESID
            for (int rep = 1; rep < REP_RES; ++rep) { pg8::EpiResid E0 = E; E0.scale = 0.f; pg8::gemm_phase<pg8::EpiResid, pg8::StaticOrder, true, true>(lds, g, S, E0, wave_s); }
            pg8::gemm_phase<pg8::EpiResid, pg8::StaticOrder, true, true>(lds, g, S, E, wave_s);
#endif
        }
        GSYNC();
        if (layer == 0) { { PHASE_IDS(); norm_phase<false>(HBUF, PIN(1) + DM, XN, gw, NGW, lane); } GSYNC(); }
        else { PHASE_IDS(); norm_phase<true>(HBUF, PIN(17), HBUF, gw, NGW, lane); }
    }
}

extern "C" void kernel_launch(void* const* d_in, const int* in_sizes, int n_in, void* d_out, int out_size, void* d_ws, size_t ws_size, hipStream_t stream) {
    static int grid_blocks = 0;
    if (grid_blocks == 0) {
        if (n_in != 18 || ws_size < WS_END) { fprintf(stderr, "kernel_launch: need 18 inputs and %zu bytes of workspace; got %d, %zu\n", (size_t)WS_END, n_in, ws_size); grid_blocks = -1; return; }
        int dev = 0, cus = 0, per_cu = 0;
        hipGetDevice(&dev);
        hipDeviceGetAttribute(&cus, hipDeviceAttributeMultiprocessorCount, dev);
        hipFuncSetAttribute((const void*)fwd_megakernel, hipFuncAttributeMaxDynamicSharedMemorySize, LDS_BYTES);
        hipOccupancyMaxActiveBlocksPerMultiprocessor(&per_cu, (const void*)fwd_megakernel, 512, LDS_BYTES);
        if (per_cu < 1) { fprintf(stderr, "kernel_launch: occupancy query says %d blocks per CU\n", per_cu); per_cu = 1; }
        (void)hipGetLastError();
        grid_blocks = cus * per_cu;
    }
    if (grid_blocks < 0) return;
    if (hipMemsetAsync((char*)d_ws + WS_CTL, 0, CTL_BYTES, stream) != hipSuccess) { fprintf(stderr, "kernel_launch: hipMemsetAsync failed\n"); return; }
    Params p{};
    for (int i = 0; i < 18; ++i) p.in[i] = (const float*)d_in[i];
    p.out = (float*)d_out; p.ws = (unsigned char*)d_ws;
    void* args[] = {&p};
    hipError_t e = hipLaunchCooperativeKernel((const void*)fwd_megakernel, dim3(grid_blocks), dim3(512), args, LDS_BYTES, stream);
    if (e != hipSuccess) fprintf(stderr, "cooperative launch failed: %s (grid %d)\n", hipGetErrorString(e), grid_blocks);
}
```
